# Optimizing an MI355X kernel written in HIP

```python
import numpy as np
import jax, jax.numpy as jnp
from jax import lax

D_MODEL = 1024
BATCH = 2
SEQ = 8192
DEPTH = 2

GRID_W = 64
CTX_LEN = 256
EPS = 1e-6

NA_HEADS = 8
NA_HEAD_DIM = 64
NA_WIDTH = NA_HEADS * NA_HEAD_DIM
NA_KH = 8
NA_KW = 16

HG_HEADS = 4
HG_KEY_DIM = 128
HG_VAL_DIM = 128
HG_KEY = HG_HEADS * HG_KEY_DIM
HG_VAL = HG_HEADS * HG_VAL_DIM
HG_CHUNK = 32

D_FF = 2816
CONV_W = 3

N_EVEN = (DEPTH + 1) // 2
N_ODD = DEPTH // 2
EV_SIZES = [NA_WIDTH, NA_WIDTH, NA_WIDTH, HG_KEY, HG_KEY, HG_KEY, HG_VAL, HG_VAL]
EV_IN = sum(EV_SIZES)
EV_SPLITS = [int(s) for s in np.cumsum(EV_SIZES)[:-1]]
EV_MIX = NA_WIDTH + HG_VAL

kernel_name = "hybrid_na_hgrn2_shortconv_dit_block"


def rms_norm(x, w):
    xf = x.astype(jnp.float32)
    y = xf * lax.rsqrt(jnp.mean(xf * xf, axis=-1, keepdims=True) + EPS)
    return (y * w.astype(jnp.float32)).astype(x.dtype)


def modulate(h, shift, scale):
    return h * (1.0 + scale[:, None, :]) + shift[:, None, :]


def dwconv3(h, w, b):
    hp = jnp.pad(h, ((0, 0), (1, 1), (0, 0)))
    return hp[:, :-2] * w[0] + hp[:, 1:-1] * w[1] + hp[:, 2:] * w[2] + b


def neighbourhood_attention(q, k, v, k_ctx, v_ctx, rpb):
    b, s, h, d = q.shape
    rows = s // GRID_W
    kh = min(NA_KH, rows)
    kw = NA_KW
    scale = d ** -0.5
    cols = np.arange(GRID_W)
    col_start = np.clip(cols - kw // 2, 0, GRID_W - kw)
    col_idx = col_start[:, None] + np.arange(kw)[None, :]
    col_rel = col_idx - cols[:, None] + (NA_KW - 1)
    rpb_c = rpb.astype(jnp.float32)[:, :, col_rel]
    qg = q.reshape(b, rows, GRID_W, h, d)
    kg = k.reshape(b, rows, GRID_W, h, d)
    vg = v.reshape(b, rows, GRID_W, h, d)

    def row_block(args):
        r, q_row = args
        r0 = jnp.clip(r - kh // 2, 0, rows - kh)
        k_rows = lax.dynamic_slice_in_dim(kg, r0, kh, axis=1)
        v_rows = lax.dynamic_slice_in_dim(vg, r0, kh, axis=1)
        k_nb = k_rows[:, :, col_idx]
        v_nb = v_rows[:, :, col_idx]
        row_rel = r0 + jnp.arange(kh) - r + (NA_KH - 1)
        bias = rpb_c[:, row_rel].transpose(0, 2, 1, 3)
        s_loc = jnp.einsum('bqhd,brqwhd->bhqrw', q_row, k_nb).astype(jnp.float32) * scale + bias[None]
        s_ctx = jnp.einsum('bqhd,bkhd->bhqk', q_row, k_ctx).astype(jnp.float32) * scale
        logits = jnp.concatenate([s_loc.reshape(b, h, GRID_W, kh * kw), s_ctx], axis=-1)
        p = jax.nn.softmax(logits, axis=-1).astype(v.dtype)
        p_loc = p[..., :kh * kw].reshape(b, h, GRID_W, kh, kw)
        p_ctx = p[..., kh * kw:]
        return (jnp.einsum('bhqrw,brqwhd->bqhd', p_loc, v_nb)
                + jnp.einsum('bhqk,bkhd->bqhd', p_ctx, v_ctx))

    out = lax.map(row_block, (jnp.arange(rows), qg.transpose(1, 0, 2, 3, 4)))
    return out.transpose(1, 0, 2, 3, 4).reshape(b, s, h, d)


def context_attention(q, k, v):
    s = jnp.einsum('bqhd,bkhd->bhqk', q, k).astype(jnp.float32) * (q.shape[-1] ** -0.5)
    p = jax.nn.softmax(s, axis=-1).astype(v.dtype)
    return jnp.einsum('bhqk,bkhd->bqhd', p, v)


def hgrn2_scan(q, k, v, log_f, s0):
    b, h, l, _ = q.shape
    n = l // HG_CHUNK

    def to_chunks(t):
        return t.reshape(b, h, n, HG_CHUNK, t.shape[-1]).transpose(2, 0, 1, 3, 4)

    causal_in_chunk = jnp.tril(jnp.ones((HG_CHUNK, HG_CHUNK), dtype=bool))

    def step(state, inp):
        qc, kc, vc, gc = inp
        bcum = jnp.cumsum(gc, axis=2)
        btot = bcum[:, :, -1:]
        qe = qc * jnp.exp(bcum)
        ke = kc * jnp.exp(-bcum)
        att = jnp.where(causal_in_chunk, jnp.einsum('bhtk,bhsk->bhts', qe, ke), 0.0)
        o = jnp.einsum('bhtk,bhkv->bhtv', qe, state) + jnp.einsum('bhts,bhsv->bhtv', att, vc)
        kd = kc * jnp.exp(btot - bcum)
        new_state = jnp.exp(btot)[:, :, 0, :, None] * state + jnp.einsum('bhsk,bhsv->bhkv', kd, vc)
        return new_state, o

    s_end, o = lax.scan(step, s0, (to_chunks(q), to_chunks(k), to_chunks(v), to_chunks(log_f)))
    return o.transpose(1, 2, 0, 3, 4).reshape(b, h, l, v.shape[-1]), s_end


def hgrn2_final_state(k, v, log_f):
    bcum = jnp.cumsum(log_f, axis=2)
    return jnp.einsum('bhtk,bhtv->bhkv', k * jnp.exp(bcum[:, :, -1:] - bcum), v)


def _heads(a, dh):
    b, l, _ = a.shape
    return a.astype(jnp.float32).reshape(b, l, -1, dh).transpose(0, 2, 1, 3)


def _hg_gates(f_pres, i, lb):
    v = _heads(i, HG_VAL_DIM)
    dirs = []
    for d, f_pre in enumerate(f_pres):
        lbd = lb[d].astype(jnp.float32).reshape(HG_HEADS, 1, HG_KEY_DIM)
        fg = lbd + (1.0 - lbd) * jax.nn.sigmoid(_heads(f_pre, HG_KEY_DIM))
        dirs.append((1.0 - fg, jnp.log(fg)))
    return v, dirs


def _hg_readout(o, g, norm_w):
    b, _, l, _ = o.shape
    o = o * lax.rsqrt(jnp.mean(o * o, axis=-1, keepdims=True) + EPS)
    o = o * norm_w.astype(jnp.float32).reshape(HG_HEADS, 1, HG_VAL_DIM)
    o = o.transpose(0, 2, 1, 3).reshape(b, l, HG_VAL)
    return (o * jax.nn.silu(g.astype(jnp.float32))).astype(g.dtype)


def hgrn2_mixer(q, fs, i, g, cq, cfs, ci, cg, lb, norm_w, with_ctx_out):
    v, dirs = _hg_gates(fs, i, lb)
    vc, dirs_c = _hg_gates(cfs, ci, lb)
    qh = jax.nn.silu(_heads(q, HG_KEY_DIM))
    if with_ctx_out:
        cqh = jax.nn.silu(_heads(cq, HG_KEY_DIM))
    b = q.shape[0]
    zero_state = jnp.zeros((b, HG_HEADS, HG_KEY_DIM, HG_VAL_DIM), jnp.float32)
    o_lat = jnp.zeros_like(qh[..., :HG_VAL_DIM])
    o_ctx = None
    for d in range(2):
        tr = (lambda a: jnp.flip(a, axis=2)) if d == 1 else (lambda a: a)
        k, lf = dirs[d]
        kc, lfc = dirs_c[d]
        if with_ctx_out:
            oc, s_ctx = hgrn2_scan(tr(cqh), tr(kc), tr(vc), tr(lfc), zero_state)
            o_ctx = tr(oc) if o_ctx is None else o_ctx + tr(oc)
        else:
            s_ctx = hgrn2_final_state(tr(kc), tr(vc), tr(lfc))
        ol, _ = hgrn2_scan(tr(qh), tr(k), tr(v), tr(lf), s_ctx)
        o_lat = o_lat + tr(ol)
    y = _hg_readout(o_lat, g, norm_w)
    y_ctx = _hg_readout(o_ctx, cg, norm_w) if with_ctx_out else None
    return y, y_ctx


def even_mixer(h, h_ctx, w_in, w_out, rpb, lb, hg_norm_w, with_ctx_out):
    b, s, _ = h.shape
    na_q, na_k, na_v, hg_q, hg_ff, hg_fb, hg_i, hg_g = jnp.split(h @ w_in, EV_SPLITS, axis=-1)
    cna_q, cna_k, cna_v, chg_q, chg_ff, chg_fb, chg_i, chg_g = jnp.split(h_ctx @ w_in, EV_SPLITS, axis=-1)

    def nh(a):
        return a.reshape(a.shape[0], a.shape[1], NA_HEADS, NA_HEAD_DIM)

    a_lat = neighbourhood_attention(nh(na_q), nh(na_k), nh(na_v), nh(cna_k), nh(cna_v), rpb)
    g_lat, g_ctx = hgrn2_mixer(hg_q, (hg_ff, hg_fb), hg_i, hg_g,
                               chg_q, (chg_ff, chg_fb), chg_i, chg_g, lb, hg_norm_w, with_ctx_out)
    y = jnp.concatenate([a_lat.reshape(b, s, NA_WIDTH), g_lat], axis=-1) @ w_out
    y_ctx = None
    if with_ctx_out:
        a_ctx = context_attention(nh(cna_q), nh(cna_k), nh(cna_v))
        y_ctx = jnp.concatenate([a_ctx.reshape(b, h_ctx.shape[1], NA_WIDTH), g_ctx], axis=-1) @ w_out
    return y, y_ctx


def short_conv_mixer(h, w_in, conv_w, conv_b, w_out):
    gate_b, gate_c, u = jnp.split(h @ w_in, 3, axis=-1)
    return (gate_b * dwconv3(gate_c * u, conv_w, conv_b)) @ w_out


def conv_ffn(h, w_up, conv_w, conv_b, w_down):
    a, val = jnp.split(h @ w_up, 2, axis=-1)
    return (jax.nn.gelu(dwconv3(a, conv_w, conv_b), approximate=False) * val) @ w_down


def setup_inputs(seed: int = 0) -> dict:
    key = jax.random.key(seed)
    ks = jax.random.split(key, 24)
    f32 = jnp.float32
    nrm = lambda k, shape, s: jax.random.normal(k, shape, f32) * s
    D = D_MODEL
    return {
        "x": nrm(ks[0], (BATCH, SEQ, D), 1.0),
        "c": nrm(ks[1], (BATCH, D), 1.0),
        "ctx": nrm(ks[2], (BATCH, CTX_LEN, D), 1.0),
        "c_ctx": nrm(ks[3], (D,), 1.0),
        "ada_w": nrm(ks[4], (DEPTH, D, 6 * D), 0.5 * D ** -0.5),
        "ada_b": nrm(ks[5], (DEPTH, 6 * D), 0.02),
        "norm_mix_w": 1.0 + nrm(ks[6], (DEPTH, D), 0.02),
        "norm_ffn_w": 1.0 + nrm(ks[7], (DEPTH, D), 0.02),
        "ev_w_in": nrm(ks[8], (N_EVEN, D, EV_IN), D ** -0.5),
        "ev_w_out": nrm(ks[9], (N_EVEN, EV_MIX, D), EV_MIX ** -0.5),
        "na_rpb": nrm(ks[10], (N_EVEN, NA_HEADS, 2 * NA_KH - 1, 2 * NA_KW - 1), 0.1),
        "hg_lb_logits": nrm(ks[11], (N_EVEN + 1, 2, HG_KEY), 0.1),
        "hg_norm_w": 1.0 + nrm(ks[12], (N_EVEN, HG_VAL), 0.02),
        "od_w_in": nrm(ks[13], (N_ODD, D, 3 * D), D ** -0.5),
        "od_conv_w": nrm(ks[14], (N_ODD, CONV_W, D), CONV_W ** -0.5),
        "od_conv_b": nrm(ks[15], (N_ODD, D), 0.02),
        "od_w_out": nrm(ks[16], (N_ODD, D, D), D ** -0.5),
        "ffn_w_up": nrm(ks[17], (DEPTH, D, 2 * D_FF), D ** -0.5),
        "ffn_conv_w": nrm(ks[18], (DEPTH, CONV_W, D_FF), CONV_W ** -0.5),
        "ffn_conv_b": nrm(ks[19], (DEPTH, D_FF), 0.02),
        "ffn_w_down": nrm(ks[20], (DEPTH, D_FF, D), D_FF ** -0.5),
        "final_norm_w": 1.0 + nrm(ks[21], (D,), 0.02),
    }


def reference(x, c, ctx, c_ctx, ada_w, ada_b, norm_mix_w, norm_ffn_w, ev_w_in, ev_w_out,
              na_rpb, hg_lb_logits, hg_norm_w, od_w_in, od_conv_w, od_conv_b, od_w_out,
              ffn_w_up, ffn_conv_w, ffn_conv_b, ffn_w_down, final_norm_w):
    lb_all = jnp.cumsum(jax.nn.softmax(hg_lb_logits.astype(jnp.float32), axis=0), axis=0)[:N_EVEN]
    silu_c = jax.nn.silu(c)
    silu_cc = jax.nn.silu(c_ctx)[None]
    xc = ctx
    for layer in range(DEPTH):
        j = layer // 2
        is_even = layer % 2 == 0
        ctx_feeds_later = any(l % 2 == 0 for l in range(layer + 1, DEPTH))
        mod = silu_c @ ada_w[layer] + ada_b[layer]
        shift_m, scale_m, gate_m, shift_f, scale_f, gate_f = jnp.split(mod, 6, axis=-1)
        if is_even or ctx_feeds_later:
            mod_c = silu_cc @ ada_w[layer] + ada_b[layer]
            cshift_m, cscale_m, cgate_m, cshift_f, cscale_f, cgate_f = jnp.split(mod_c, 6, axis=-1)
            h_ctx = modulate(rms_norm(xc, norm_mix_w[layer]), cshift_m, cscale_m)
        h = modulate(rms_norm(x, norm_mix_w[layer]), shift_m, scale_m)
        if is_even:
            y, y_ctx = even_mixer(h, h_ctx, ev_w_in[j], ev_w_out[j], na_rpb[j], lb_all[j],
                                  hg_norm_w[j], ctx_feeds_later)
        else:
            y = short_conv_mixer(h, od_w_in[j], od_conv_w[j], od_conv_b[j], od_w_out[j])
            y_ctx = (short_conv_mixer(h_ctx, od_w_in[j], od_conv_w[j], od_conv_b[j], od_w_out[j])
                     if ctx_feeds_later else None)
        x = x + gate_m[:, None, :] * y
        h = modulate(rms_norm(x, norm_ffn_w[layer]), shift_f, scale_f)
        x = x + gate_f[:, None, :] * conv_ffn(h, ffn_w_up[layer], ffn_conv_w[layer],
                                              ffn_conv_b[layer], ffn_w_down[layer])
        if ctx_feeds_later:
            xc = xc + cgate_m[:, None, :] * y_ctx
            hc = modulate(rms_norm(xc, norm_ffn_w[layer]), cshift_f, cscale_f)
            xc = xc + cgate_f[:, None, :] * conv_ffn(hc, ffn_w_up[layer], ffn_conv_w[layer],
                                                     ffn_conv_b[layer], ffn_w_down[layer])
    return rms_norm(x, final_norm_w)
```

```cpp
#include <hip/hip_runtime.h>
#include <hip/hip_cooperative_groups.h>
#include <cstdio>
#include <cstdint>
namespace cg = cooperative_groups;

#ifndef DUP7
#define DUP7 1
#endif
#ifndef DUPPA
#define DUPPA 1
#endif
#ifndef DUP2
#define DUP2 1
#endif
#ifndef DUPNA
#define DUPNA 1
#endif
#ifndef DUP3
#define DUP3 1
#endif
#ifndef DUP5
#define DUP5 1
#endif
#ifndef MK_SINGLE
#define MK_SINGLE 1
#endif

#define LAS __attribute__((address_space(3)))
typedef unsigned short bf16_t;
typedef short bf16x8 __attribute__((ext_vector_type(8)));
typedef float f32x4 __attribute__((ext_vector_type(4)));
typedef float f32x2 __attribute__((ext_vector_type(2)));
typedef unsigned u32x4 __attribute__((ext_vector_type(4)));
typedef unsigned u32x2 __attribute__((ext_vector_type(2)));

constexpr int D = 1024, SEQ = 8192, M = 16384, MC = 512, MT = M + MC, CTXL = 256;
constexpr int DFF = 2816, EVN = 4096;
constexpr float EPS = 1e-6f;
constexpr float LOG2E = 1.4426950408889634f, LN2 = 0.6931471805599453f;
constexpr size_t PLANE = (size_t)MT * 512;
constexpr int NCHAIN = 16, NCH = 128, NCHT = 132;

constexpr size_t MiB = 1u << 20;
constexpr size_t WS_MOD = 0;
constexpr size_t WS_SB = 128 * 1024;
constexpr size_t WS_SSQ = 256 * 1024;
constexpr size_t WS_BAR = 512 * 1024;
constexpr size_t WS_CNT = WS_BAR + 16384;
constexpr size_t WS_XS = 640 * 1024;
constexpr size_t WS_ZERO_LO = WS_SB, WS_ZERO_BYTES = WS_CNT + 16384 - WS_SB;
constexpr size_t WS_HDEC = 1 * MiB;
constexpr size_t WS_HKVC = 3 * MiB;
constexpr size_t WS_WIN = 5 * MiB;
constexpr size_t WS_WOUT = 13 * MiB;
constexpr size_t WS_ODIN = 15 * MiB;
constexpr size_t WS_ODOUT = 21 * MiB;
constexpr size_t WS_UP = 23 * MiB;
constexpr size_t WS_DOWN = 45 * MiB;
constexpr size_t WS_HA = 56 * MiB;
constexpr size_t WS_PROJ = 90 * MiB;
constexpr size_t WS_MIX = 222 * MiB;
constexpr size_t WS_END = 254 * MiB;

constexpr int STAGE_BYTES = 131072;
constexpr int XCH_OFF = STAGE_BYTES;
constexpr int NA_WAVE_BYTES = 19280;
constexpr int LDS_BYTES = 152 * 1024;
static_assert(8 * NA_WAVE_BYTES <= LDS_BYTES && XCH_OFF + 4096 <= LDS_BYTES, "lds");

__device__ __forceinline__ float bf2f(unsigned h) { return __builtin_bit_cast(float, h << 16); }
typedef __bf16 bf16x2_t __attribute__((ext_vector_type(2)));
__device__ __forceinline__ unsigned cvt_pk_bf16(float lo, float hi) { const f32x2 v = {lo, hi}; const bf16x2_t b = __builtin_convertvector(v, bf16x2_t); return __builtin_bit_cast(unsigned, b); }
__device__ __forceinline__ float fexp2(float x) { return __builtin_amdgcn_exp2f(x); }
__device__ __forceinline__ float fexp(float x) { return __builtin_amdgcn_exp2f(x * LOG2E); }
__device__ __forceinline__ float flog(float x) { return __builtin_amdgcn_logf(x) * LN2; }
__device__ __forceinline__ float frcp(float x) { return __builtin_amdgcn_rcpf(x); }
__device__ __forceinline__ float fsigmoid(float x) { return frcp(1.0f + fexp(-x)); }
__device__ __forceinline__ float fsilu(float x) { return x * fsigmoid(x); }
#define LDS_WAIT() asm volatile("s_waitcnt lgkmcnt(0)" ::: "memory")
__device__ __forceinline__ float wave_sum(float v) {
#pragma unroll
    for (int o = 1; o < 64; o <<= 1) v += __shfl_xor(v, o);
    return v;
}
__device__ __forceinline__ float xg_max(float x) {
    const unsigned u = __builtin_bit_cast(unsigned, x);
    const auto r = __builtin_amdgcn_permlane16_swap(u, u, false, false);
    const float m = fmaxf(__builtin_bit_cast(float, (unsigned)r[0]), __builtin_bit_cast(float, (unsigned)r[1]));
    const unsigned v = __builtin_bit_cast(unsigned, m);
    const auto q = __builtin_amdgcn_permlane32_swap(v, v, false, false);
    return fmaxf(__builtin_bit_cast(float, (unsigned)q[0]), __builtin_bit_cast(float, (unsigned)q[1]));
}
__device__ __forceinline__ float xg_sum(float x) {
    const unsigned u = __builtin_bit_cast(unsigned, x);
    const auto r = __builtin_amdgcn_permlane16_swap(u, u, false, false);
    const float m = __builtin_bit_cast(float, (unsigned)r[0]) + __builtin_bit_cast(float, (unsigned)r[1]);
    const unsigned v = __builtin_bit_cast(unsigned, m);
    const auto q = __builtin_amdgcn_permlane32_swap(v, v, false, false);
    return __builtin_bit_cast(float, (unsigned)q[0]) + __builtin_bit_cast(float, (unsigned)q[1]);
}
template <int CTRL> __device__ __forceinline__ float dppf(float old, float src) {
    return __builtin_bit_cast(float, __builtin_amdgcn_update_dpp(__builtin_bit_cast(int, old), __builtin_bit_cast(int, src), CTRL, 0xF, 0xF, false));
}
__device__ __forceinline__ f32x2 gelu_pk(f32x2 v) {
    const f32x2 av = __builtin_elementwise_abs(v), d = av * 0.2316418882f + 1.0f;
    f32x2 t; t.x = __builtin_amdgcn_rcpf(d.x); t.y = __builtin_amdgcn_rcpf(d.y);
    f32x2 q = t * 0.5307027145f + (-0.7265760135f); q = q * t + 0.7107068705f; q = q * t + (-0.142248368f); q = q * t + 0.127414796f; q = q * t;
    const f32x2 s = (v * v) * (-0.72134752044f);
    f32x2 e; e.x = __builtin_amdgcn_exp2f(s.x); e.y = __builtin_amdgcn_exp2f(s.y);
    const f32x2 m = v * (q * e), r = v - m;
    f32x2 o; o.x = v.x < 0.f ? m.x : r.x; o.y = v.y < 0.f ? m.y : r.y; return o;
}

namespace pg8 {
constexpr int BM = 256, BK = 64, HALF = 128, HTB = HALF * BK * 2, NXCD = 8, WGM = 8;
__host__ __device__ __forceinline__ int lds_byte(int r, int c) { const int st = (r >> 4) * 2 + (c >> 5), rr = r & 15, cc = c & 31, ob = rr * 64 + cc * 2; return st * 1024 + (ob ^ (((ob >> 9) & 1) << 5)); }
__host__ __device__ __forceinline__ void stage_rc(int b, int& R, int& C) { const int st = b / 1024, sb = b % 1024, swz = sb ^ (((sb >> 9) & 1) << 5); R = (st >> 1) * 16 + swz / 64; C = (st & 1) * 32 + (swz % 64) / 2; }
__host__ __device__ __forceinline__ int perm32(int rho) { const int n = rho >> 4, i = rho & 15; return 8 * (i >> 2) + 4 * n + (i & 3); }

struct Unit { int pm, pn, arow; };
struct Gemm { const bf16_t* A; const bf16_t* Bt; int K; };

template <bool OVL> struct StaticOrder {
    int nM, nN, nwg, G, c;
    __device__ void init(int nM_, int nN_, int G_, int c_) { nM = nM_; nN = nN_; nwg = nM * nN; G = G_; c = c_; }
    __device__ bool next(int i, Unit& u) const {
        const long L = (long)i * G + c; if (L >= nwg) return false;
        int wgid = (int)L; { const int q = nwg / NXCD, r = nwg % NXCD, xcd = wgid % NXCD, off = wgid / NXCD; wgid = (xcd < r ? xcd * (q + 1) : r * (q + 1) + (xcd - r) * q) + off; }
        const int nig = WGM * nN, gid = wgid / nig, fm = gid * WGM, gsz = (nM - fm) < WGM ? (nM - fm) : WGM;
        u.pm = fm + ((wgid % nig) % gsz); u.pn = (wgid % nig) / gsz;
        if (OVL) { const int b = u.pm / 33, ti = u.pm % 33; u.arow = b * SEQ + 254 * ti - 1; } else u.arow = u.pm * BM;
        return true;
    }
};

template <class Epi, class Sched>
__device__ __forceinline__ void gemm_phase(LAS unsigned char* lds, const Gemm g, const Sched& S, const Epi& E) {
    const int tid = threadIdx.x, wid = __builtin_amdgcn_readfirstlane(tid >> 6), lane = tid & 63, wr = wid >> 2, wc = wid & 3, fr = lane & 15, fq = lane >> 4;
    const int K = g.K, nt = K / BK;
    unsigned voffA[2], voffB[2];
#pragma unroll
    for (int i = 0; i < 2; ++i) { int R, C; stage_rc(tid * 16 + i * 8192, R, C); const int Rb = (R & ~31) + perm32(R & 31);
        voffA[i] = (unsigned)(R * K + C) * 2u; voffB[i] = (unsigned)(Rb * K + C) * 2u; }
    const size_t kstep = (size_t)(BK * 2);
    const size_t hstep = (size_t)HALF * K * 2;
    const size_t tstep = 2 * hstep;
    const size_t rstep = (size_t)K * 2;
    const unsigned ldsw = (unsigned)wid * 1024u;
    const int aoff = lds_byte(wr * 64 + fr, fq * 8), boff = lds_byte(wc * 32 + fr, fq * 8);
#define PG8_SA(b, h) (((b) * 2 + (h)) * HTB)
#define PG8_SB(b, h) ((4 + (b) * 2 + (h)) * HTB)
#define PG8_STAGE(bufoff, gbase, voff) do { _Pragma("unroll") for (int _i = 0; _i < 2; ++_i) \
        __builtin_amdgcn_global_load_lds((const unsigned*)((const char*)(gbase) + (voff)[_i]), (LAS unsigned*)(lds + (bufoff) + ldsw + _i * 8192), 16, 0, 0); } while (0)
#define PG8_LDA(dst, b, h) do { _Pragma("unroll") for (int m = 0; m < 4; ++m) _Pragma("unroll") for (int k = 0; k < 2; ++k) dst[m][k] = *(const LAS bf16x8*)(lds + PG8_SA(b, h) + aoff + m * 2048 + k * 1024); } while (0)
#define PG8_LDB(dst, b, h) do { _Pragma("unroll") for (int n = 0; n < 2; ++n) _Pragma("unroll") for (int k = 0; k < 2; ++k) dst[n][k] = *(const LAS bf16x8*)(lds + PG8_SB(b, h) + boff + n * 2048 + k * 1024); } while (0)
#define PG8_MMA(ai, bj, At, Bt) do { __builtin_amdgcn_s_setprio(1); _Pragma("unroll") for (int m = 0; m < 4; ++m) _Pragma("unroll") for (int n = 0; n < 2; ++n) _Pragma("unroll") for (int k = 0; k < 2; ++k) \
        acc[ai][bj][m][n] = __builtin_amdgcn_mfma_f32_16x16x32_bf16(Bt[n][k], At[m][k], acc[ai][bj][m][n], 0, 0, 0); __builtin_amdgcn_s_setprio(0); } while (0)
#define PG8_WAIT_V(n) asm volatile("s_waitcnt vmcnt(" #n ")" ::: "memory")
#define PG8_WAIT_L(n) asm volatile("s_waitcnt lgkmcnt(" #n ")" ::: "memory")
#define PG8_BAR __builtin_amdgcn_s_barrier()
#define PG8_SCHED __builtin_amdgcn_sched_barrier(0)
    Unit cur, nxt; int ui = 0;
    if (!S.next(0, cur)) return;
    f32x4 acc[2][2][4][2];
#pragma unroll
    for (int a = 0; a < 2; ++a)
#pragma unroll
        for (int b = 0; b < 2; ++b)
#pragma unroll
            for (int m = 0; m < 4; ++m)
#pragma unroll
                for (int n = 0; n < 2; ++n) acc[a][b][m][n] = (f32x4){0.f, 0.f, 0.f, 0.f};
    bf16x8 At[4][2], B0[2][2], B1[2][2];
    const char* cA = (const char*)g.A + (long)cur.arow * (long)rstep; const char* cB = (const char*)g.Bt + (size_t)cur.pn * tstep;
    PG8_STAGE(PG8_SB(0, 0), cB, voffB); PG8_STAGE(PG8_SB(0, 1), cB + hstep, voffB); PG8_STAGE(PG8_SA(0, 0), cA, voffA); PG8_STAGE(PG8_SA(0, 1), cA + hstep, voffA);
    if (wr == 1) PG8_BAR;
    PG8_WAIT_V(2); PG8_BAR;
    PG8_STAGE(PG8_SB(1, 0), cB + kstep, voffB); PG8_STAGE(PG8_SA(1, 0), cA + kstep, voffA); PG8_STAGE(PG8_SB(1, 1), cB + hstep + kstep, voffB);
    PG8_WAIT_V(6); PG8_BAR;
    for (;;) {
        const bool has_next = S.next(ui + 1, nxt);
        const char* nA = has_next ? (const char*)g.A + (long)nxt.arow * (long)rstep : cA; const char* nB = has_next ? (const char*)g.Bt + (size_t)nxt.pn * tstep : cB;
        for (int t = 0; t < nt; t += 2) {
            const bool last = (t == nt - 2);
            const char* a1 = cA + (size_t)(t + 1) * kstep;
            const char* a2 = last ? nA : cA + (size_t)(t + 2) * kstep; const char* b2 = last ? nB : cB + (size_t)(t + 2) * kstep;
            const char* a3 = a2 + kstep; const char* b3 = b2 + kstep;
            PG8_LDB(B0, 0, 0); PG8_LDB(B1, 0, 1); PG8_SCHED; PG8_LDA(At, 0, 0); PG8_STAGE(PG8_SA(1, 1), a1 + hstep, voffA);
            PG8_WAIT_V(8); PG8_WAIT_L(0); PG8_BAR; PG8_MMA(0, 0, At, B0); PG8_MMA(0, 1, At, B1); PG8_BAR; PG8_SCHED;
            PG8_LDA(At, 0, 1); PG8_STAGE(PG8_SB(0, 0), b2, voffB); PG8_STAGE(PG8_SB(0, 1), b2 + hstep, voffB); PG8_STAGE(PG8_SA(0, 0), a2, voffA);
            PG8_WAIT_V(8); PG8_WAIT_L(0); PG8_BAR; PG8_MMA(1, 0, At, B0); PG8_MMA(1, 1, At, B1); PG8_BAR; PG8_SCHED;
            PG8_LDB(B0, 1, 0); PG8_LDB(B1, 1, 1); PG8_SCHED; PG8_LDA(At, 1, 0); PG8_STAGE(PG8_SA(0, 1), a2 + hstep, voffA);
            PG8_WAIT_V(8); PG8_WAIT_L(0); PG8_BAR; PG8_MMA(0, 0, At, B0); PG8_MMA(0, 1, At, B1); PG8_BAR; PG8_SCHED;
            PG8_LDA(At, 1, 1); PG8_STAGE(PG8_SB(1, 0), b3, voffB); PG8_STAGE(PG8_SB(1, 1), b3 + hstep, voffB); PG8_STAGE(PG8_SA(1, 0), a3, voffA);
            PG8_WAIT_V(8); PG8_WAIT_L(0); PG8_BAR; PG8_MMA(1, 0, At, B0); PG8_MMA(1, 1, At, B1); PG8_BAR; PG8_SCHED;
        }
        if (wr == 0) PG8_BAR;
        E(acc, cur, wr, wc, fr, fq);
        if (!has_next) break;
#pragma unroll
        for (int a = 0; a < 2; ++a)
#pragma unroll
            for (int b = 0; b < 2; ++b)
#pragma unroll
                for (int m = 0; m < 4; ++m)
#pragma unroll
                    for (int n = 0; n < 2; ++n) acc[a][b][m][n] = (f32x4){0.f, 0.f, 0.f, 0.f};
        cur = nxt; cA = nA; cB = nB; ++ui;
        if (wr == 1) PG8_BAR;
    }
    PG8_WAIT_V(0);
    PG8_BAR;
#undef PG8_SA
#undef PG8_SB
#undef PG8_STAGE
#undef PG8_LDA
#undef PG8_LDB
#undef PG8_MMA
#undef PG8_WAIT_V
#undef PG8_WAIT_L
#undef PG8_BAR
#undef PG8_SCHED
}

typedef f32x4 Acc[2][2][4][2];

struct EpiStoreBf16 {
    bf16_t* O; int ldc;
    __device__ __forceinline__ void operator()(Acc& acc, const Unit& u, int wr, int wc, int fr, int fq) const {
        const int row0 = u.pm * BM + wr * 64 + fr, col0 = u.pn * BM + wc * 32 + 8 * fq;
#pragma unroll
        for (int ai = 0; ai < 2; ++ai)
#pragma unroll
            for (int m = 0; m < 4; ++m) { bf16_t* rowp = O + (size_t)(row0 + ai * HALF + m * 16) * ldc + col0;
#pragma unroll
                for (int bj = 0; bj < 2; ++bj) { const f32x4 v0 = acc[ai][bj][m][0], v1 = acc[ai][bj][m][1];
                    u32x4 w; w.x = cvt_pk_bf16(v0[0], v0[1]); w.y = cvt_pk_bf16(v0[2], v0[3]); w.z = cvt_pk_bf16(v1[0], v1[1]); w.w = cvt_pk_bf16(v1[2], v1[3]);
                    *(u32x4*)(rowp + bj * HALF) = w; } }
    }
};
struct EpiProj {
    bf16_t* O; const float* lbl;
    __device__ __forceinline__ void operator()(Acc& acc, const Unit& u, int wr, int wc, int fr, int fq) const {
        const int gidx = u.pn >> 1, row0 = u.pm * BM + wr * 64 + fr;
        bf16_t* base = O + (size_t)gidx * PLANE;
#pragma unroll
        for (int bj = 0; bj < 2; ++bj) {
            const int cg = (u.pn & 1) * 256 + bj * HALF + wc * 32 + 8 * fq;
            const int hd = gidx < 3 ? 64 : 128, h = gidx < 3 ? (cg >> 6) : (cg >> 7), d = cg & (hd - 1);
            float lb[8];
            if (gidx == 4 || gidx == 5) {
#pragma unroll
                for (int i = 0; i < 8; ++i) { const int k = (gidx - 4) * 512 + cg + i; lb[i] = 1.0f / (1.0f + expf(lbl[1024 + k] - lbl[k])); }
            }
#pragma unroll
            for (int ai = 0; ai < 2; ++ai)
#pragma unroll
                for (int m = 0; m < 4; ++m) {
                    const int row = row0 + ai * HALF + m * 16;
                    float v[8];
#pragma unroll
                    for (int i = 0; i < 8; ++i) v[i] = (i < 4) ? acc[ai][bj][m][0][i & 3] : acc[ai][bj][m][1][i & 3];
                    if (gidx == 3 || gidx == 7) {
#pragma unroll
                        for (int i = 0; i < 8; ++i) v[i] = fsilu(v[i]);
                    } else if (gidx == 4 || gidx == 5) {
#pragma unroll
                        for (int i = 0; i < 8; ++i) v[i] = flog(lb[i] + (1.0f - lb[i]) * fsigmoid(v[i]));
                    }
                    u32x4 w; w.x = cvt_pk_bf16(v[0], v[1]); w.y = cvt_pk_bf16(v[2], v[3]); w.z = cvt_pk_bf16(v[4], v[5]); w.w = cvt_pk_bf16(v[6], v[7]);
                    if (gidx == 2) {
                        bf16_t* vp = base + ((size_t)h * MT + (row & ~63) + d) * 64 + (row & 63);
#pragma unroll
                        for (int i = 0; i < 8; ++i) vp[i * 64] = (bf16_t)((i & 1) ? (w[i >> 1] >> 16) : (w[i >> 1] & 0xffffu));
                    } else {
                        *(u32x4*)(base + ((size_t)h * MT + row) * hd + d) = w;
                    }
                }
        }
    }
};
template <bool NRM> struct EpiResid {
    const float* xin; float* xout; const float* gate; bf16_t* HAo; const float* nw; const float* scale; float* ssq;
    __device__ __forceinline__ void operator()(Acc& acc, const Unit& u, int wr, int wc, int fr, int fq) const {
        const int row0 = u.pm * BM + wr * 64 + fr, col0 = u.pn * BM + wc * 32 + 8 * fq;
        const int bidx = (u.pm * BM) >> 13;
        const float* gp = gate + (size_t)bidx * 6144 + col0;
        f32x4 gv[2][2], gg[2][2];
#pragma unroll
        for (int bj = 0; bj < 2; ++bj)
#pragma unroll
            for (int n = 0; n < 2; ++n) { gv[bj][n] = *(const f32x4*)(gp + bj * HALF + 4 * n);
                if (NRM) gg[bj][n] = *(const f32x4*)(nw + col0 + bj * HALF + 4 * n) * (*(const f32x4*)(scale + (size_t)bidx * 6144 + col0 + bj * HALF + 4 * n) + 1.0f); }
#pragma unroll
        for (int ai = 0; ai < 2; ++ai)
#pragma unroll
            for (int m = 0; m < 4; ++m) { const int row = row0 + ai * HALF + m * 16; const size_t ro = (size_t)row * D + col0; float ss = 0.f;
#pragma unroll
                for (int bj = 0; bj < 2; ++bj) { f32x4 xo[2];
#pragma unroll
                    for (int n = 0; n < 2; ++n) { const f32x4 xi = *(const f32x4*)(xin + ro + bj * HALF + 4 * n);
                        xo[n] = xi + gv[bj][n] * acc[ai][bj][m][n];
                        *(f32x4*)(xout + ro + bj * HALF + 4 * n) = xo[n]; }
                    if (NRM) { ss += (xo[0][0] * xo[0][0] + xo[0][1] * xo[0][1]) + (xo[0][2] * xo[0][2] + xo[0][3] * xo[0][3]) + (xo[1][0] * xo[1][0] + xo[1][1] * xo[1][1]) + (xo[1][2] * xo[1][2] + xo[1][3] * xo[1][3]);
                        const f32x4 y0 = xo[0] * gg[bj][0], y1 = xo[1] * gg[bj][1];
                        u32x4 w; w.x = cvt_pk_bf16(y0[0], y0[1]); w.y = cvt_pk_bf16(y0[2], y0[3]); w.z = cvt_pk_bf16(y1[0], y1[1]); w.w = cvt_pk_bf16(y1[2], y1[3]);
                        *(u32x4*)(HAo + ro + bj * HALF) = w; } }
                if (NRM) { ss = xg_sum(ss); if (fq == 0) atomicAdd(ssq + row, ss); } }
    }
};
template <bool XF32> struct EpiResidB {
    const void* xin; const float* nwp; const float* scp; const float* gate; bf16_t* HAo; const float* nw; const float* scale; float* ssq;
    __device__ __forceinline__ void operator()(Acc& acc, const Unit& u, int wr, int wc, int fr, int fq) const {
        const int row0 = u.pm * BM + wr * 64 + fr, col0 = u.pn * BM + wc * 32 + 8 * fq;
        const int bidx = (u.pm * BM) >> 13;
        const float* gp = gate + (size_t)bidx * 6144 + col0;
        f32x4 gv[2][2], gg[2][2], rg[2][2];
#pragma unroll
        for (int bj = 0; bj < 2; ++bj)
#pragma unroll
            for (int n = 0; n < 2; ++n) { gv[bj][n] = *(const f32x4*)(gp + bj * HALF + 4 * n);
                gg[bj][n] = *(const f32x4*)(nw + col0 + bj * HALF + 4 * n) * (*(const f32x4*)(scale + (size_t)bidx * 6144 + col0 + bj * HALF + 4 * n) + 1.0f);
                if (!XF32) { const f32x4 gpv = *(const f32x4*)(nwp + col0 + bj * HALF + 4 * n) * (*(const f32x4*)(scp + (size_t)bidx * 6144 + col0 + bj * HALF + 4 * n) + 1.0f);
                    rg[bj][n] = (f32x4){1.0f / gpv[0], 1.0f / gpv[1], 1.0f / gpv[2], 1.0f / gpv[3]}; } }
#pragma unroll
        for (int ai = 0; ai < 2; ++ai)
#pragma unroll
            for (int m = 0; m < 4; ++m) { const int row = row0 + ai * HALF + m * 16; const size_t ro = (size_t)row * D + col0; float ss = 0.f;
#pragma unroll
                for (int bj = 0; bj < 2; ++bj) { f32x4 xi[2];
                    if (XF32) { xi[0] = *(const f32x4*)((const float*)xin + ro + bj * HALF); xi[1] = *(const f32x4*)((const float*)xin + ro + bj * HALF + 4); }
                    else { const u32x4 xb = *(const u32x4*)((const bf16_t*)xin + ro + bj * HALF);
                        xi[0] = (f32x4){bf2f(xb.x & 0xffffu), bf2f(xb.x >> 16), bf2f(xb.y & 0xffffu), bf2f(xb.y >> 16)};
                        xi[1] = (f32x4){bf2f(xb.z & 0xffffu), bf2f(xb.z >> 16), bf2f(xb.w & 0xffffu), bf2f(xb.w >> 16)};
                        xi[0] = xi[0] * rg[bj][0]; xi[1] = xi[1] * rg[bj][1]; }
                    const f32x4 x0 = xi[0] + gv[bj][0] * acc[ai][bj][m][0], x1 = xi[1] + gv[bj][1] * acc[ai][bj][m][1];
                    ss += (x0[0] * x0[0] + x0[1] * x0[1]) + (x0[2] * x0[2] + x0[3] * x0[3]) + (x1[0] * x1[0] + x1[1] * x1[1]) + (x1[2] * x1[2] + x1[3] * x1[3]);
                    const f32x4 y0 = x0 * gg[bj][0], y1 = x1 * gg[bj][1];
                    u32x4 w; w.x = cvt_pk_bf16(y0[0], y0[1]); w.y = cvt_pk_bf16(y0[2], y0[3]); w.z = cvt_pk_bf16(y1[0], y1[1]); w.w = cvt_pk_bf16(y1[2], y1[3]);
                    *(u32x4*)(HAo + ro + bj * HALF) = w; }
                ss = xg_sum(ss); if (fq == 0) atomicAdd(ssq + row, ss); }
    }
};
struct EpiResidOut {
    const bf16_t* xin; const float* nwp; const float* scp; float* xout; const float* gate;
    __device__ __forceinline__ void operator()(Acc& acc, const Unit& u, int wr, int wc, int fr, int fq) const {
        const int row0 = u.pm * BM + wr * 64 + fr, col0 = u.pn * BM + wc * 32 + 8 * fq;
        const float* gp = gate + (size_t)((u.pm * BM) >> 13) * 6144 + col0;
#pragma unroll
        for (int ai = 0; ai < 2; ++ai)
#pragma unroll
            for (int m = 0; m < 4; ++m) { const size_t ro = (size_t)(row0 + ai * HALF + m * 16) * D + col0;
#pragma unroll
                for (int bj = 0; bj < 2; ++bj) { const u32x4 xb = *(const u32x4*)(xin + ro + bj * HALF);
                    const f32x4 g0 = *(const f32x4*)(gp + bj * HALF), g1 = *(const f32x4*)(gp + bj * HALF + 4);
                    const size_t so = (size_t)((u.pm * BM) >> 13) * 6144 + col0 + bj * HALF;
                    const f32x4 p0 = *(const f32x4*)(nwp + col0 + bj * HALF) * (*(const f32x4*)(scp + so) + 1.0f), p1 = *(const f32x4*)(nwp + col0 + bj * HALF + 4) * (*(const f32x4*)(scp + so + 4) + 1.0f);
                    *(f32x4*)(xout + ro + bj * HALF) = (f32x4){bf2f(xb.x & 0xffffu) / p0[0], bf2f(xb.x >> 16) / p0[1], bf2f(xb.y & 0xffffu) / p0[2], bf2f(xb.y >> 16) / p0[3]} + g0 * acc[ai][bj][m][0];
                    *(f32x4*)(xout + ro + bj * HALF + 4) = (f32x4){bf2f(xb.z & 0xffffu) / p1[0], bf2f(xb.z >> 16) / p1[1], bf2f(xb.w & 0xffffu) / p1[2], bf2f(xb.w >> 16) / p1[3]} + g1 * acc[ai][bj][m][1]; } }
    }
};
struct EpiResidFinal {
    const bf16_t* xin; const float* nwp; const float* scp; float* out; const float* gate; const float* fw; float* xs; unsigned* cnt; LAS float* sl;
    __device__ __forceinline__ void operator()(Acc& acc, const Unit& u, int wr, int wc, int fr, int fq) const {
        const int row0 = u.pm * BM + wr * 64 + fr, col0 = u.pn * BM + wc * 32 + 8 * fq, tid = threadIdx.x;
        const float* gp = gate + (size_t)((u.pm * BM) >> 13) * 6144 + col0;
        {
            f32x4 gv[2][2], rg[2][2];
#pragma unroll
            for (int bj = 0; bj < 2; ++bj)
#pragma unroll
                for (int n = 0; n < 2; ++n) { gv[bj][n] = *(const f32x4*)(gp + bj * HALF + 4 * n);
                    const f32x4 gpv = *(const f32x4*)(nwp + col0 + bj * HALF + 4 * n) * (*(const f32x4*)(scp + (size_t)((u.pm * BM) >> 13) * 6144 + col0 + bj * HALF + 4 * n) + 1.0f);
                    rg[bj][n] = (f32x4){1.0f / gpv[0], 1.0f / gpv[1], 1.0f / gpv[2], 1.0f / gpv[3]}; }
#pragma unroll
            for (int ai = 0; ai < 2; ++ai)
#pragma unroll
                for (int m = 0; m < 4; ++m) { const size_t ro = (size_t)(row0 + ai * HALF + m * 16) * D + col0; float ss = 0.f;
#pragma unroll
                    for (int bj = 0; bj < 2; ++bj) { const u32x4 xb = *(const u32x4*)(xin + ro + bj * HALF);
#pragma unroll
                        for (int n = 0; n < 2; ++n) { const unsigned w0 = n ? xb.z : xb.x, w1 = n ? xb.w : xb.y;
                            const f32x4 xi = (f32x4){bf2f(w0 & 0xffffu), bf2f(w0 >> 16), bf2f(w1 & 0xffffu), bf2f(w1 >> 16)} * rg[bj][n]; const f32x4 xo = xi + gv[bj][n] * acc[ai][bj][m][n];
                            acc[ai][bj][m][n] = xo; ss += (xo[0] * xo[0] + xo[1] * xo[1]) + (xo[2] * xo[2] + xo[3] * xo[3]); } }
                    ss = xg_sum(ss);
                    if (fq == 0) sl[wc * 256 + ai * HALF + wr * 64 + m * 16 + fr] = ss; }
        }
        __syncthreads();
        if (tid < 256) { const float t = (sl[tid] + sl[256 + tid]) + (sl[512 + tid] + sl[768 + tid]);
            __hip_atomic_store(xs + ((size_t)u.pm * 4 + u.pn) * 256 + tid, t, __ATOMIC_RELAXED, __HIP_MEMORY_SCOPE_AGENT); }
        asm volatile("s_waitcnt vmcnt(0)" ::: "memory");
        __syncthreads();
        if (tid == 0) { unsigned* c = cnt + u.pm * 64;
            __hip_atomic_fetch_add(c, 1u, __ATOMIC_RELAXED, __HIP_MEMORY_SCOPE_AGENT);
            unsigned sp = 0;
            while (__hip_atomic_load(c, __ATOMIC_RELAXED, __HIP_MEMORY_SCOPE_AGENT) < 4u) { __builtin_amdgcn_s_sleep(1); if (++sp > (1u << 22)) break; } }
        __syncthreads();
        if (tid < 256) { float t = 0.f;
#pragma unroll
            for (int pn = 0; pn < 4; ++pn) t += __hip_atomic_load(xs + ((size_t)u.pm * 4 + pn) * 256 + tid, __ATOMIC_RELAXED, __HIP_MEMORY_SCOPE_AGENT);
            sl[1024 + tid] = __builtin_amdgcn_rsqf(t * (1.f / D) + EPS); }
        __syncthreads();
        f32x4 fv[2][2];
#pragma unroll
        for (int bj = 0; bj < 2; ++bj)
#pragma unroll
            for (int n = 0; n < 2; ++n) fv[bj][n] = *(const f32x4*)(fw + col0 + bj * HALF + 4 * n);
#pragma unroll
        for (int ai = 0; ai < 2; ++ai)
#pragma unroll
            for (int m = 0; m < 4; ++m) { const size_t ro = (size_t)(row0 + ai * HALF + m * 16) * D + col0; const float r = sl[1024 + ai * HALF + wr * 64 + m * 16 + fr];
#pragma unroll
                for (int bj = 0; bj < 2; ++bj)
#pragma unroll
                    for (int n = 0; n < 2; ++n) *(f32x4*)(out + ro + bj * HALF + 4 * n) = acc[ai][bj][m][n] * r * fv[bj][n]; }
    }
};
struct EpiConvGlu {
    bf16_t* T; const float* cw; const float* cb; LAS float* xch; const float* ssq; const float* sb;
    __device__ __forceinline__ void operator()(Acc& acc, const Unit& u, int wr, int wc, int fr, int fq) const {
        const int b = u.pm / 33, ti = u.pm % 33, t0 = 254 * ti - 1;
        const int lc = wc * 32 + 8 * fq, fc = u.pn * 128 + lc;
        f32x4 w0[2], w1[2], w2[2], bb[2];
#pragma unroll
        for (int n = 0; n < 2; ++n) { w0[n] = *(const f32x4*)(cw + fc + 4 * n); w1[n] = *(const f32x4*)(cw + DFF + fc + 4 * n); w2[n] = *(const f32x4*)(cw + 2 * DFF + fc + 4 * n); bb[n] = *(const f32x4*)(cb + fc + 4 * n); }
        LAS float* xf = xch; LAS float* xl = xch + 512;
        f32x4 sba[2], sbv[2];
#pragma unroll
        for (int n = 0; n < 2; ++n) { sba[n] = *(const f32x4*)(sb + (size_t)b * 2 * DFF + u.pn * 256 + lc + 4 * n); sbv[n] = *(const f32x4*)(sb + (size_t)b * 2 * DFF + u.pn * 256 + 128 + lc + 4 * n); }
#pragma unroll
        for (int ai = 0; ai < 2; ++ai) {
#pragma unroll
            for (int m = 0; m < 4; ++m) { const int tok = t0 + ai * HALF + wr * 64 + m * 16 + fr;
                if ((unsigned)tok >= (unsigned)SEQ) { acc[ai][0][m][0] = (f32x4){0.f, 0.f, 0.f, 0.f}; acc[ai][0][m][1] = (f32x4){0.f, 0.f, 0.f, 0.f}; }
                else { const float rr = __builtin_amdgcn_rsqf(ssq[b * SEQ + tok] * (1.f / D) + EPS);
                    acc[ai][0][m][0] = acc[ai][0][m][0] * rr + sba[0]; acc[ai][0][m][1] = acc[ai][0][m][1] * rr + sba[1];
                    acc[ai][1][m][0] = acc[ai][1][m][0] * rr + sbv[0]; acc[ai][1][m][1] = acc[ai][1][m][1] * rr + sbv[1]; } }
            const int rg = 2 * ai + wr;
            if (fr == 0) { *(LAS f32x4*)(xf + rg * 128 + lc) = acc[ai][0][0][0]; *(LAS f32x4*)(xf + rg * 128 + lc + 4) = acc[ai][0][0][1]; }
            if (fr == 15) { *(LAS f32x4*)(xl + rg * 128 + lc) = acc[ai][0][3][0]; *(LAS f32x4*)(xl + rg * 128 + lc + 4) = acc[ai][0][3][1]; }
        }
        __syncthreads();
#pragma unroll
        for (int ai = 0; ai < 2; ++ai) {
            const int rg = 2 * ai + wr;
            f32x4 pv[2], nv[2];
#pragma unroll
            for (int n = 0; n < 2; ++n) { pv[n] = rg > 0 ? *(const LAS f32x4*)(xl + (rg - 1) * 128 + lc + 4 * n) : (f32x4){0.f, 0.f, 0.f, 0.f};
                nv[n] = rg < 3 ? *(const LAS f32x4*)(xf + (rg + 1) * 128 + lc + 4 * n) : (f32x4){0.f, 0.f, 0.f, 0.f}; }
#pragma unroll
            for (int m = 0; m < 4; ++m) {
                const int lr = ai * HALF + wr * 64 + m * 16 + fr, tok = t0 + lr;
                f32x4 r[2];
#pragma unroll
                for (int n = 0; n < 2; ++n) {
#pragma unroll
                    for (int i = 0; i < 4; ++i) {
                        const float cur = acc[ai][0][m][n][i];
                        const float oldp = (m > 0) ? dppf<0x121>(0.f, acc[ai][0][m > 0 ? m - 1 : 0][n][i]) : pv[n][i];
                        const float prev = dppf<0x111>(oldp, cur);
                        const float oldn = (m < 3) ? dppf<0x12F>(0.f, acc[ai][0][m < 3 ? m + 1 : 3][n][i]) : nv[n][i];
                        const float next = dppf<0x101>(oldn, cur);
                        r[n][i] = w0[n][i] * prev + w1[n][i] * cur + w2[n][i] * next + bb[n][i];
                    }
                }
                const f32x2 g0 = gelu_pk((f32x2){r[0][0], r[0][1]}), g1 = gelu_pk((f32x2){r[0][2], r[0][3]}), g2 = gelu_pk((f32x2){r[1][0], r[1][1]}), g3 = gelu_pk((f32x2){r[1][2], r[1][3]});
                const f32x4 v0 = acc[ai][1][m][0], v1 = acc[ai][1][m][1];
                u32x4 w; w.x = cvt_pk_bf16(g0.x * v0[0], g0.y * v0[1]); w.y = cvt_pk_bf16(g1.x * v0[2], g1.y * v0[3]); w.z = cvt_pk_bf16(g2.x * v1[0], g2.y * v1[1]); w.w = cvt_pk_bf16(g3.x * v1[2], g3.y * v1[3]);
                if (lr >= 1 && lr <= 254 && tok < SEQ) *(u32x4*)(T + (size_t)(b * SEQ + tok) * DFF + fc) = w;
            }
        }
    }
};
struct EpiMulPair {
    bf16_t* P; const float* ssq; const float* sb;
    __device__ __forceinline__ void operator()(Acc& acc, const Unit& u, int wr, int wc, int fr, int fq) const {
        const int row0 = u.pm * BM + wr * 64 + fr, col0 = u.pn * 128 + wc * 32 + 8 * fq;
        const float* sp = sb + (size_t)((u.pm * BM) >> 13) * 3072 + u.pn * 256 + wc * 32 + 8 * fq;
        f32x4 s0[2], s1[2];
#pragma unroll
        for (int n = 0; n < 2; ++n) { s0[n] = *(const f32x4*)(sp + 4 * n); s1[n] = *(const f32x4*)(sp + 128 + 4 * n); }
#pragma unroll
        for (int ai = 0; ai < 2; ++ai)
#pragma unroll
            for (int m = 0; m < 4; ++m) { const float rr = __builtin_amdgcn_rsqf(ssq[row0 + ai * HALF + m * 16] * (1.f / D) + EPS);
                const f32x4 v0 = (acc[ai][0][m][0] * rr + s0[0]) * (acc[ai][1][m][0] * rr + s1[0]), v1 = (acc[ai][0][m][1] * rr + s0[1]) * (acc[ai][1][m][1] * rr + s1[1]);
                u32x4 w; w.x = cvt_pk_bf16(v0[0], v0[1]); w.y = cvt_pk_bf16(v0[2], v0[3]); w.z = cvt_pk_bf16(v1[0], v1[1]); w.w = cvt_pk_bf16(v1[2], v1[3]);
                *(u32x4*)(P + (size_t)(row0 + ai * HALF + m * 16) * D + col0) = w; }
    }
};
struct EpiGateConv {
    const bf16_t* P; bf16_t* Z; const float* cw; const float* cb; const float* ssq; const float* sb;
    __device__ __forceinline__ void operator()(Acc& acc, const Unit& u, int wr, int wc, int fr, int fq) const {
        const int row0 = u.pm * BM + wr * 64 + fr;
        float rr[2][4];
#pragma unroll
        for (int ai = 0; ai < 2; ++ai)
#pragma unroll
            for (int m = 0; m < 4; ++m) rr[ai][m] = __builtin_amdgcn_rsqf(ssq[row0 + ai * HALF + m * 16] * (1.f / D) + EPS);
#pragma unroll
        for (int bj = 0; bj < 2; ++bj) {
            const int col0 = u.pn * BM + bj * HALF + wc * 32 + 8 * fq;
            float w0[8], w1[8], w2[8], bb[8], sg[8];
#pragma unroll
            for (int i = 0; i < 8; ++i) { w0[i] = cw[col0 + i]; w1[i] = cw[D + col0 + i]; w2[i] = cw[2 * D + col0 + i]; bb[i] = cb[col0 + i]; sg[i] = sb[(size_t)((u.pm * BM) >> 13) * 3072 + 2048 + col0 + i]; }
#pragma unroll
            for (int ai = 0; ai < 2; ++ai)
#pragma unroll
                for (int m = 0; m < 4; ++m) {
                    const int row = row0 + ai * HALF + m * 16, tok = row & (SEQ - 1);
                    const bf16_t* pp = P + (size_t)row * D + col0;
                    const u32x4 z4 = (u32x4){0u, 0u, 0u, 0u};
                    const u32x4 pc = *(const u32x4*)pp;
                    u32x4 pe = z4;
                    if (fr == 0 && tok > 0) pe = *(const u32x4*)(pp - D);
                    if (fr == 15 && tok < SEQ - 1) pe = *(const u32x4*)(pp + D);
                    u32x4 pm, pn;
#pragma unroll
                    for (int q = 0; q < 4; ++q) { pm[q] = (unsigned)__builtin_amdgcn_update_dpp((int)pe[q], (int)pc[q], 0x111, 0xF, 0xF, false);
                        pn[q] = (unsigned)__builtin_amdgcn_update_dpp((int)pe[q], (int)pc[q], 0x101, 0xF, 0xF, false); }
                    float o[8];
#pragma unroll
                    for (int i = 0; i < 8; ++i) {
                        const unsigned sh = (i & 1) ? 16u : 0u;
                        const float c = bf2f((pc[i >> 1] >> sh) & 0xffffu), pr = bf2f((pm[i >> 1] >> sh) & 0xffffu), nx = bf2f((pn[i >> 1] >> sh) & 0xffffu);
                        const float a = ((i < 4) ? acc[ai][bj][m][0][i & 3] : acc[ai][bj][m][1][i & 3]) * rr[ai][m] + sg[i];
                        o[i] = a * (w0[i] * pr + w1[i] * c + w2[i] * nx + bb[i]);
                    }
                    u32x4 w; w.x = cvt_pk_bf16(o[0], o[1]); w.y = cvt_pk_bf16(o[2], o[3]); w.z = cvt_pk_bf16(o[4], o[5]); w.w = cvt_pk_bf16(o[6], o[7]);
                    *(u32x4*)(Z + (size_t)row * D + col0) = w;
                }
        }
    }
};
}

template <int MAP> __device__ __forceinline__ int map_row(int n0) {
    if (MAP == 0) return n0;
    if (MAP == 1) { if (n0 < DFF) return (n0 >> 7) * 256 + (n0 & 127); const int n = n0 - DFF; return (n >> 7) * 256 + 128 + (n & 127); }
    if (n0 < 1024) return 2048 + n0;
    if (n0 < 2048) { const int n = n0 - 1024; return (n >> 7) * 256 + (n & 127); }
    const int n = n0 - 2048; return (n >> 7) * 256 + 128 + (n & 127);
}
template <int MAP, bool BIAS> __device__ __forceinline__ void transpose_item(const float* W, int K, int N, bf16_t* WT, LAS float* scr, int item, int lane,
                                                                           const LAS float* shift = nullptr, float* sb = nullptr, int sbs = 0) {
    const int nblk = N / 32, kb = item / nblk, nb = item % nblk, k0 = 64 * kb, n0 = 32 * nb;
    float p0 = 0.f, p1 = 0.f;
#pragma unroll 8
    for (int i = 0; i < 32; ++i) { const int kk = 2 * i + (lane >> 5); const float w = __builtin_nontemporal_load(W + (size_t)(k0 + kk) * N + n0 + (lane & 31)); scr[kk * 33 + (lane & 31)] = w;
        if (BIAS) { p0 += w * shift[k0 + kk]; p1 += w * shift[1024 + k0 + kk]; } }
    LDS_WAIT();
    const int c = lane & 7, r0 = map_row<MAP>(n0);
    if (BIAS) {
        const unsigned u0 = __builtin_bit_cast(unsigned, p0), u1 = __builtin_bit_cast(unsigned, p1);
        const auto q0 = __builtin_amdgcn_permlane32_swap(u0, u0, false, false); const auto q1 = __builtin_amdgcn_permlane32_swap(u1, u1, false, false);
        const float t0 = __builtin_bit_cast(float, (unsigned)q0[0]) + __builtin_bit_cast(float, (unsigned)q0[1]), t1 = __builtin_bit_cast(float, (unsigned)q1[0]) + __builtin_bit_cast(float, (unsigned)q1[1]);
        if (lane < 32) { atomicAdd(sb + r0 + lane, t0); atomicAdd(sb + sbs + r0 + lane, t1); }
    }
#pragma unroll
    for (int j = 0; j < 4; ++j) { const int n = (lane >> 3) + 8 * j; const LAS float* s = scr + (8 * c) * 33 + n;
        u32x4 o; o.x = cvt_pk_bf16(s[0 * 33], s[1 * 33]); o.y = cvt_pk_bf16(s[2 * 33], s[3 * 33]); o.z = cvt_pk_bf16(s[4 * 33], s[5 * 33]); o.w = cvt_pk_bf16(s[6 * 33], s[7 * 33]);
        *(u32x4*)(WT + (size_t)(r0 + n) * K + k0 + 8 * c) = o; }
    LDS_WAIT();
}
__device__ __forceinline__ void norm_mod_row(const float* xrow, const float* w, const float* shift, const float* scale, bf16_t* orow, int lane) {
    f32x4 v[4]; float s = 0.f;
#pragma unroll
    for (int j = 0; j < 4; ++j) { v[j] = __builtin_nontemporal_load((const f32x4*)(xrow + 4 * lane + 256 * j)); s += (v[j].x * v[j].x + v[j].y * v[j].y) + (v[j].z * v[j].z + v[j].w * v[j].w); }
    const float r = __builtin_amdgcn_rsqf(wave_sum(s) * (1.f / D) + EPS);
#pragma unroll
    for (int j = 0; j < 4; ++j) { const int c = 4 * lane + 256 * j;
        const f32x4 ww = *(const f32x4*)(w + c), sh = *(const f32x4*)(shift + c), sc = *(const f32x4*)(scale + c);
        const f32x4 y = v[j] * r * ww * (sc + 1.0f) + sh;
        u32x2 o; o.x = cvt_pk_bf16(y.x, y.y); o.y = cvt_pk_bf16(y.z, y.w);
        *(u32x2*)(orow + c) = o; }
}

#define XB_TMO      128
#define XB_XCNT(j)  (256  + 64 * (j))
#define XB_XSUB(j)  (1280 + 64 * (j))
#define XB_XGEN(j)  (2304 + 64 * (j))
#define XB_TOP      3328
#define XB_TOPGEN   3392
#define XCD_BAR_WORDS 3456
#define XB_SPIN_CAP (1u << 18)
__device__ __forceinline__ unsigned xb_ld(unsigned* p)              { return __hip_atomic_load(p, __ATOMIC_RELAXED, __HIP_MEMORY_SCOPE_AGENT); }
__device__ __forceinline__ unsigned xb_add(unsigned* p, unsigned v) { return __hip_atomic_fetch_add(p, v, __ATOMIC_RELAXED, __HIP_MEMORY_SCOPE_AGENT); }
__device__ __forceinline__ unsigned xb_xcc_id() { return (unsigned)__builtin_amdgcn_s_getreg((3 << 11) | 20) & 0xFu; }
#define XB_SPIN(cond, bar) do { unsigned _sp = 0; while (cond) { __builtin_amdgcn_s_sleep(1); \
    if ((++_sp & 255u) == 0u) { if (xb_ld(&(bar)[XB_TMO])) break; if (_sp > XB_SPIN_CAP) { atomicAdd(&(bar)[XB_TMO], 1u); break; } } } } while (0)
struct XcdBarrier { unsigned* bar; unsigned x; volatile LAS unsigned* st; };
__device__ __forceinline__ XcdBarrier xcd_barrier_post(unsigned* bar, volatile LAS unsigned* st) {
    XcdBarrier b; b.bar = bar; b.x = xb_xcc_id(); b.st = st;
    if (threadIdx.x == 0) (void)xb_add(&bar[XB_XCNT(b.x)], 1u);
    return b;
}
__device__ __forceinline__ void xcd_barrier_complete(unsigned* bar, unsigned x, unsigned& nloc, unsigned& nx) {
    const unsigned G = gridDim.x * gridDim.y * gridDim.z;
    unsigned sum, cnt, mine, sp = 0u;
    for (;;) {
        sum = 0u; cnt = 0u; mine = 0u;
#pragma unroll
        for (unsigned j = 0; j < 16; ++j) { const unsigned c = xb_ld(&bar[XB_XCNT(j)]); sum += c; cnt += (c > 0u) ? 1u : 0u; mine = (j == x) ? c : mine; }
        if (sum == G) break;
        __builtin_amdgcn_s_sleep(1);
        if ((++sp & 255u) == 0u) { if (xb_ld(&bar[XB_TMO])) break; if (sp > XB_SPIN_CAP) { atomicAdd(&bar[XB_TMO], 1u); break; } }
    }
    nloc = mine > 0u ? mine : 1u; nx = cnt > 0u ? cnt : 1u;
}
__device__ __forceinline__ void xcd_barrier(const XcdBarrier& b) {
    asm volatile("s_waitcnt vmcnt(0)" ::: "memory");
    __syncthreads();
    if (threadIdx.x == 0) {
        unsigned* bar = b.bar;
        __builtin_amdgcn_s_waitcnt(0);
        unsigned nloc = b.st[0], nx = b.st[1];
        if (nloc == 0u) { xcd_barrier_complete(bar, b.x, nloc, nx); b.st[0] = nloc; b.st[1] = nx; }
        const unsigned old = xb_add(&bar[XB_XSUB(b.x)], 1u);
        const unsigned gen = old / nloc;
        if (old + 1u == (gen + 1u) * nloc) {
            __builtin_amdgcn_fence(__ATOMIC_RELEASE, "agent");
            asm volatile("s_waitcnt vmcnt(0)" ::: "memory");
            const unsigned og = xb_add(&bar[XB_TOP], 1u);
            const unsigned tg = og / nx;
            if (og + 1u == (tg + 1u) * nx) xb_add(&bar[XB_TOPGEN], 1u);
            else XB_SPIN(xb_ld(&bar[XB_TOPGEN]) == tg, bar);
            __builtin_amdgcn_fence(__ATOMIC_ACQUIRE, "agent");
            xb_add(&bar[XB_XGEN(b.x)], 1u);
            asm volatile("s_waitcnt vmcnt(0)" ::: "memory");
        } else {
            XB_SPIN(xb_ld(&bar[XB_XGEN(b.x)]) == gen, bar);
            __builtin_amdgcn_fence(__ATOMIC_ACQUIRE, "agent");
            asm volatile("s_waitcnt vmcnt(0)" ::: "memory");
        }
    }
    __syncthreads();
}
__device__ __forceinline__ void norm_mod_row2(const float* x0, const float* x1, const float* w, const float* shift, const float* scale, bf16_t* o0, bf16_t* o1, int lane) {
    f32x4 v0[4], v1[4]; float s0 = 0.f, s1 = 0.f;
#pragma unroll
    for (int j = 0; j < 4; ++j) { v0[j] = *(const f32x4*)(x0 + 4 * lane + 256 * j); v1[j] = *(const f32x4*)(x1 + 4 * lane + 256 * j); }
#pragma unroll
    for (int j = 0; j < 4; ++j) { s0 += (v0[j].x * v0[j].x + v0[j].y * v0[j].y) + (v0[j].z * v0[j].z + v0[j].w * v0[j].w); s1 += (v1[j].x * v1[j].x + v1[j].y * v1[j].y) + (v1[j].z * v1[j].z + v1[j].w * v1[j].w); }
    const float r0 = __builtin_amdgcn_rsqf(wave_sum(s0) * (1.f / D) + EPS), r1 = __builtin_amdgcn_rsqf(wave_sum(s1) * (1.f / D) + EPS);
#pragma unroll
    for (int j = 0; j < 4; ++j) { const int c = 4 * lane + 256 * j;
        const f32x4 ww = *(const f32x4*)(w + c), sh = *(const f32x4*)(shift + c), sc = *(const f32x4*)(scale + c);
        const f32x4 g = ww * (sc + 1.0f), y0 = v0[j] * r0 * g + sh, y1 = v1[j] * r1 * g + sh;
        u32x2 a; a.x = cvt_pk_bf16(y0.x, y0.y); a.y = cvt_pk_bf16(y0.z, y0.w); *(u32x2*)(o0 + c) = a;
        u32x2 b; b.x = cvt_pk_bf16(y1.x, y1.y); b.y = cvt_pk_bf16(y1.z, y1.w); *(u32x2*)(o1 + c) = b; }
}

struct Args {
    const float *x, *c, *ctx, *c_ctx, *ada_w, *ada_b, *norm_mix_w, *norm_ffn_w, *ev_w_in, *ev_w_out, *na_rpb, *hg_lb, *hg_norm_w,
        *od_w_in, *od_conv_w, *od_conv_b, *od_w_out, *ffn_w_up, *ffn_conv_w, *ffn_conv_b, *ffn_w_down, *final_norm_w;
    float* out; unsigned char* ws;
    int ph_lo, ph_hi;
};

#define NA_SKIPK(qt, sb, kt) (LAT && (((qt) == 1 && (sb) == 1 && (kt) == 1) || ((qt) == 2 && (sb) == 0 && (kt) == 0)))
template <bool LAT>
__device__ __forceinline__ void na_kblock(const LAS unsigned char* Ks, const LAS unsigned char* Vt, const LAS float* Bs, const bf16x8 (&Qf)[4][2], f32x4 (&O)[4][4], float (&mrun)[4], float (&lrun)[4],
                                          int rrel31, int fr, int g) {
    const float SC = 0.125f * LOG2E;
#pragma unroll
    for (int sb = 0; sb < 2; ++sb) {
        int g4 = g * 4 + sb * 32; asm volatile("" : "+v"(g4));
        bf16x8 Ak[2][2];
#pragma unroll
        for (int kt = 0; kt < 2; ++kt)
#pragma unroll
            for (int kk = 0; kk < 2; ++kk) { const int key = sb * 32 + kt * 16 + fr, ch = kk * 4 + g;
                Ak[kt][kk] = *(const LAS bf16x8*)(Ks + key * 128 + ((ch ^ (key & 7)) * 16)); }
#pragma unroll
        for (int qt = 0; qt < 4; ++qt) {
            if (LAT && ((qt == 3 && sb == 0) || (qt == 0 && sb == 1))) continue;
            f32x4 S[2];
#pragma unroll
            for (int kt = 0; kt < 2; ++kt) { S[kt] = (f32x4){0.f, 0.f, 0.f, 0.f};
                if (NA_SKIPK(qt, sb, kt)) continue;
#pragma unroll
                for (int kk = 0; kk < 2; ++kk) S[kt] = __builtin_amdgcn_mfma_f32_16x16x32_bf16(Ak[kt][kk], Qf[qt][kk], S[kt], 0, 0, 0); }
            const int q = qt * 16 + fr, cs = min(max(q - 8, 0), 48);
            float z[2][4]; float mx = -1e30f;
#pragma unroll
            for (int kt = 0; kt < 2; ++kt)
#pragma unroll
                for (int j = 0; j < 4; ++j) {
                    if (NA_SKIPK(qt, sb, kt)) { z[kt][j] = 0.f; continue; }
                    float zz = S[kt][j] * SC;
                    if (LAT) { const int kc = g4 + kt * 16 + j; const bool valid = (unsigned)(kc - cs) < 16u;
                        const int bi = valid ? rrel31 + kc - q + 15 : 465;
                        zz += Bs[bi]; }
                    z[kt][j] = zz; mx = fmaxf(mx, zz);
                }
            __builtin_amdgcn_sched_barrier(0);
            mx = xg_max(mx);
            const float mnew = fmaxf(mrun[qt], mx), alpha = fexp2(mrun[qt] - mnew);
            mrun[qt] = mnew;
            float ps = 0.f;
#pragma unroll
            for (int kt = 0; kt < 2; ++kt)
#pragma unroll
                for (int j = 0; j < 4; ++j) { if (NA_SKIPK(qt, sb, kt)) continue; z[kt][j] = fexp2(z[kt][j] - mnew); ps += z[kt][j]; }
            lrun[qt] = lrun[qt] * alpha + ps;
            u32x4 pk; pk.x = cvt_pk_bf16(z[0][0], z[0][1]); pk.y = cvt_pk_bf16(z[0][2], z[0][3]); pk.z = cvt_pk_bf16(z[1][0], z[1][1]); pk.w = cvt_pk_bf16(z[1][2], z[1][3]);
            const bf16x8 Pb = __builtin_bit_cast(bf16x8, pk);
#pragma unroll
            for (int dt = 0; dt < 4; ++dt) {
                const LAS unsigned char* vp = Vt + (dt * 16 + fr) * 144 + (sb * 32 + g * 4) * 2;
                const u32x2 lo = *(const LAS u32x2*)vp, hi = *(const LAS u32x2*)(vp + 32);
                const bf16x8 A = __builtin_bit_cast(bf16x8, (u32x4){lo.x, lo.y, hi.x, hi.y});
                O[dt][qt] = __builtin_amdgcn_mfma_f32_16x16x32_bf16(A, Pb, O[dt][qt] * alpha, 0, 0, 0);
            }
        }
    }
}
__device__ __forceinline__ void na_stage(LAS unsigned char* Ks, LAS unsigned char* Vt, const bf16_t* __restrict__ proj, size_t krow0, int h, int lane) {
    LDS_WAIT();
#pragma unroll 4
    for (int it = 0; it < 8; ++it) { const int key = it * 8 + (lane >> 3), ch = lane & 7;
        const u32x4 v = *(const u32x4*)(proj + PLANE + ((size_t)h * MT + krow0 + key) * 64 + ch * 8);
        *(LAS u32x4*)(Ks + key * 128 + ((ch ^ (key & 7)) * 16)) = v; }
    asm volatile("" ::: "memory");
#pragma unroll 4
    for (int it = 0; it < 8; ++it) { const int d = it * 8 + (lane >> 3), ch = lane & 7;
        const u32x4 v = *(const u32x4*)(proj + 2 * PLANE + ((size_t)h * MT + krow0 + d) * 64 + ch * 8);
        *(LAS u32x4*)(Vt + d * 144 + ch * 16) = v; }
    LDS_WAIT();
}
__device__ __forceinline__ void na_item(LAS unsigned char* lds, const bf16_t* __restrict__ proj, const float* __restrict__ rpb, bf16_t* __restrict__ mix, int item, int wid, int lane) {
    const int b = item >> 7, r = item & 127, h = wid, fr = lane & 15, g = lane >> 4;
    LAS unsigned char* Ks = lds + wid * NA_WAVE_BYTES;
    LAS unsigned char* Vt = Ks + 8192;
    LAS float* Bs = (LAS float*)(Vt + 9216);
    for (int i = lane; i < 466; i += 64) Bs[i] = i < 465 ? rpb[h * 465 + i] * LOG2E : -1e30f;
    const int r0 = min(max(r - 4, 0), 120);
    const size_t qrow0 = (size_t)(b * SEQ + r * 64);
    bf16x8 Qf[4][2];
#pragma unroll
    for (int qt = 0; qt < 4; ++qt)
#pragma unroll
        for (int kk = 0; kk < 2; ++kk) Qf[qt][kk] = *(const bf16x8*)(proj + ((size_t)h * MT + qrow0 + qt * 16 + fr) * 64 + kk * 32 + g * 8);
    f32x4 O[4][4];
    float mrun[4], lrun[4];
#pragma unroll
    for (int a = 0; a < 4; ++a) { mrun[a] = -1e4f; lrun[a] = 0.f;
#pragma unroll
        for (int c = 0; c < 4; ++c) O[a][c] = (f32x4){0.f, 0.f, 0.f, 0.f}; }
#pragma unroll 1
    for (int kb = 0; kb < 8; ++kb) {
        na_stage(Ks, Vt, proj, (size_t)(b * SEQ + (r0 + kb) * 64), h, lane);
        na_kblock<true>(Ks, Vt, Bs, Qf, O, mrun, lrun, ((r0 + kb) - r + 7) * 31, fr, g);
    }
#pragma unroll 1
    for (int kb = 0; kb < 4; ++kb) {
        na_stage(Ks, Vt, proj, (size_t)(M + b * CTXL + kb * 64), h, lane);
        na_kblock<false>(Ks, Vt, Bs, Qf, O, mrun, lrun, 0, fr, g);
    }
#pragma unroll
    for (int qt = 0; qt < 4; ++qt) {
        float l = xg_sum(lrun[qt]);
        const float inv = 1.0f / l;
        bf16_t* op = mix + (qrow0 + qt * 16 + fr) * D + h * 64 + g * 4;
#pragma unroll
        for (int dt = 0; dt < 4; ++dt) { const f32x4 o = O[dt][qt] * inv; u32x2 w; w.x = cvt_pk_bf16(o[0], o[1]); w.y = cvt_pk_bf16(o[2], o[3]); *(u32x2*)(op + dt * 16) = w; }
    }
    LDS_WAIT();
}

struct HgGeom { int b, h, dir; size_t row0; };

__device__ __forceinline__ float hg_lb(const float* lbl, int dir, int k) {
    const float l0 = lbl[dir * 512 + k], l1 = lbl[1024 + dir * 512 + k];
    return 1.0f / (1.0f + expf(l1 - l0));
}

#define BAR_LDS() do { asm volatile("s_waitcnt lgkmcnt(0)" ::: "memory"); __builtin_amdgcn_s_barrier(); asm volatile("" ::: "memory"); } while (0)
struct Raw16 { unsigned short v[16]; };
__device__ __forceinline__ Raw16 hg_load16(const bf16_t* __restrict__ proj, int grp, int h, size_t row0, int seg, int kd, bool rev) {
    Raw16 r; const bf16_t* P = proj + (size_t)grp * PLANE + ((size_t)h * MT + row0) * 128 + kd;
#pragma unroll
    for (int i = 0; i < 16; ++i) { const int tn = rev ? 16 * seg + 15 - i : 16 * seg + i; r.v[i] = P[tn * 128]; }
    return r;
}
__device__ __forceinline__ void hg_write_vt(LAS unsigned char* VT, const Raw16& vv, int kd, int seg) {
    u32x4 a, bq;
    a.x = vv.v[0] | ((unsigned)vv.v[1] << 16); a.y = vv.v[2] | ((unsigned)vv.v[3] << 16); a.z = vv.v[4] | ((unsigned)vv.v[5] << 16); a.w = vv.v[6] | ((unsigned)vv.v[7] << 16);
    bq.x = vv.v[8] | ((unsigned)vv.v[9] << 16); bq.y = vv.v[10] | ((unsigned)vv.v[11] << 16); bq.z = vv.v[12] | ((unsigned)vv.v[13] << 16); bq.w = vv.v[14] | ((unsigned)vv.v[15] << 16);
    *(LAS u32x4*)(VT + kd * 144 + seg * 32) = a; *(LAS u32x4*)(VT + kd * 144 + seg * 32 + 16) = bq;
}
struct PAItem { int chain, ci, dir, h; size_t row0; };
__device__ __forceinline__ PAItem pa_item(int it) {
    PAItem I; I.chain = it / NCHT; I.ci = it % NCHT; I.dir = I.chain & 1; I.h = (I.chain >> 1) & 3; const int b = I.chain >> 3;
    if (I.ci < 4) { const int a0 = I.dir ? CTXL - 64 * (I.ci + 1) : 64 * I.ci; I.row0 = (size_t)(M + b * CTXL + a0); }
    else { const int j = I.ci - 4; const int a0 = I.dir ? SEQ - 64 * (j + 1) : 64 * j; I.row0 = (size_t)(b * SEQ + a0); }
    return I;
}
__device__ __forceinline__ void hg_passA_phase(LAS unsigned char* lds, const bf16_t* __restrict__ proj, const float* __restrict__ lbl, bf16_t* __restrict__ STATE, bf16_t* __restrict__ HKVC,
                                               float* __restrict__ HDEC, int bid, int G, int tid) {
    LAS unsigned char* KDT = lds;
    LAS unsigned char* VT = lds + 18432;
    LAS float* SEG = (LAS float*)(lds + 36864);
    const int seg = tid >> 7, kd = tid & 127, wid = tid >> 6, lane = tid & 63, fr = lane & 15, g = lane >> 4;
    const int NIT = NCHAIN * NCHT;
    int it = bid;
    if (it >= NIT) return;
    PAItem I = pa_item(it);
    Raw16 fr_ = hg_load16(proj, 4 + I.dir, I.h, I.row0, seg, kd, I.dir != 0);
    Raw16 vr_ = hg_load16(proj, 6, I.h, I.row0, seg, kd, false);
    for (; it < NIT; it += G) {
        const PAItem C = I;
        float c[16], kk[16];
#pragma unroll
        for (int i = 0; i < 16; ++i) { c[i] = bf2f(fr_.v[i]); kk[i] = 1.0f - fexp(c[i]); }
#pragma unroll
        for (int i = 1; i < 16; ++i) c[i] += c[i - 1];
        SEG[seg * 128 + kd] = c[15];
        hg_write_vt(VT, vr_, kd, seg);
        asm volatile("" ::: "memory");
        if (it + G < NIT) { I = pa_item(it + G);
            fr_ = hg_load16(proj, 4 + I.dir, I.h, I.row0, seg, kd, I.dir != 0);
            vr_ = hg_load16(proj, 6, I.h, I.row0, seg, kd, false); }
        BAR_LDS();
        const float s0 = SEG[kd], s1 = SEG[128 + kd], s2 = SEG[256 + kd], s3 = SEG[384 + kd];
        const float btot = (s0 + s1) + (s2 + s3);
        float off;
        if (C.dir == 0) off = (seg > 0 ? s0 : 0.f) + (seg > 1 ? s1 : 0.f) + (seg > 2 ? s2 : 0.f);
        else off = (seg < 3 ? s3 : 0.f) + (seg < 2 ? s2 : 0.f) + (seg < 1 ? s1 : 0.f);
#pragma unroll
        for (int i = 0; i < 16; ++i) { const int tn = C.dir ? 16 * seg + 15 - i : 16 * seg + i;
            const float kdv = kk[i] * fexp(btot - (off + c[i]));
            *(LAS unsigned short*)(KDT + kd * 144 + tn * 2) = (unsigned short)(cvt_pk_bf16(kdv, 0.f) & 0xffffu); }
        if (seg == 0) HDEC[((size_t)C.chain * NCHT + C.ci) * 128 + kd] = fexp(btot);
        BAR_LDS();
        bf16_t* STout = C.ci < 4 ? HKVC + ((size_t)C.chain * 4 + C.ci) * 16384 : STATE + ((size_t)C.chain * NCH + (C.ci - 4)) * 16384;
        bf16x8 A[2];
#pragma unroll
        for (int kb = 0; kb < 2; ++kb) A[kb] = *(const LAS bf16x8*)(KDT + (wid * 16 + fr) * 144 + (kb * 32 + g * 8) * 2);
#pragma unroll
        for (int vt = 0; vt < 8; ++vt) {
            f32x4 acc = (f32x4){0.f, 0.f, 0.f, 0.f};
#pragma unroll
            for (int kb = 0; kb < 2; ++kb) { const bf16x8 Bv = *(const LAS bf16x8*)(VT + (vt * 16 + fr) * 144 + (kb * 32 + g * 8) * 2);
                acc = __builtin_amdgcn_mfma_f32_16x16x32_bf16(A[kb], Bv, acc, 0, 0, 0); }
            u32x2 w; w.x = cvt_pk_bf16(acc[0], acc[1]); w.y = cvt_pk_bf16(acc[2], acc[3]);
            *(u32x2*)(STout + (size_t)(vt * 16 + fr) * 128 + wid * 16 + g * 4) = w;
        }
        BAR_LDS();
    }
}

__device__ __forceinline__ void hg_passC_phase(LAS unsigned char* lds, const bf16_t* __restrict__ proj, const float* __restrict__ lbl, const float* __restrict__ hnw,
                                               const bf16_t* __restrict__ STATE, bf16_t* __restrict__ mix, int bid, int G, int tid) {
    LAS unsigned char* QE = lds;
    LAS unsigned char* KE = lds + 17408;
    LAS unsigned char* QI = lds + 34816;
    LAS unsigned char* VT = lds + 52224;
    LAS float* SEG = (LAS float*)(lds + 70656);
    LAS float* RED = (LAS float*)(lds + 72704);
    const int seg = tid >> 7, kd = tid & 127, wid = tid >> 6, lane = tid & 63, fr = lane & 15, g = lane >> 4;
    const int tt = wid & 3, vh = wid >> 2;
    const int NITEM = 8 * NCH;
    if (bid >= NITEM) return;
    const int nsteps = 2 * ((NITEM - bid + G - 1) / G);
    Raw16 fq_f, fq_q, vraw;
    { const int it0 = bid, bh = it0 / NCH, jn = it0 % NCH, b = bh >> 2, h = bh & 3; const size_t row0 = (size_t)(b * SEQ + jn * 64);
      fq_f = hg_load16(proj, 4, h, row0, seg, kd, false); fq_q = hg_load16(proj, 3, h, row0, seg, kd, false);
      vraw = hg_load16(proj, 6, h, row0, seg, kd, false); }
    f32x4 O[4];
    for (int s = 0; s < nsteps; ++s) {
        const int item = bid + (s >> 1) * G, dir = s & 1, bh = item / NCH, jn = item % NCH, b = bh >> 2, h = bh & 3;
        const size_t row0 = (size_t)(b * SEQ + jn * 64);
        if (dir == 0) {
            hg_write_vt(VT, vraw, kd, seg);
#pragma unroll
            for (int vt = 0; vt < 4; ++vt) O[vt] = (f32x4){0.f, 0.f, 0.f, 0.f};
        }
        float c[16], kk[16], qs[16];
#pragma unroll
        for (int i = 0; i < 16; ++i) { c[i] = bf2f(fq_f.v[i]); kk[i] = 1.0f - fexp(c[i]); qs[i] = bf2f(fq_q.v[i]); }
#pragma unroll
        for (int i = 1; i < 16; ++i) c[i] += c[i - 1];
        SEG[seg * 128 + kd] = c[15];
        asm volatile("" ::: "memory");
        const int chain = (b * 4 + h) * 2 + dir, js = dir ? (NCH - 1 - jn) : jn;
        const bf16_t* ST = STATE + ((size_t)chain * NCH + js) * 16384;
        bf16x8 As[4][4];
#pragma unroll
        for (int vt = 0; vt < 4; ++vt)
#pragma unroll
            for (int kb = 0; kb < 4; ++kb) As[vt][kb] = *(const bf16x8*)(ST + (size_t)((vh * 4 + vt) * 16 + fr) * 128 + kb * 32 + g * 8);
        if (s + 1 < nsteps) {
            const int ni = bid + ((s + 1) >> 1) * G, nd = (s + 1) & 1, nbh = ni / NCH, njn = ni % NCH, nb = nbh >> 2, nh = nbh & 3; const size_t nrow0 = (size_t)(nb * SEQ + njn * 64);
            fq_f = hg_load16(proj, 4 + nd, nh, nrow0, seg, kd, nd != 0); fq_q = hg_load16(proj, 3, nh, nrow0, seg, kd, nd != 0);
            if (nd == 0) vraw = hg_load16(proj, 6, nh, nrow0, seg, kd, false);
        }
        BAR_LDS();
        const float s0 = SEG[kd], s1 = SEG[128 + kd], s2 = SEG[256 + kd], s3 = SEG[384 + kd];
        float off, bmid;
        if (dir == 0) { off = (seg > 0 ? s0 : 0.f) + (seg > 1 ? s1 : 0.f) + (seg > 2 ? s2 : 0.f); bmid = s0 + s1; }
        else { off = (seg < 3 ? s3 : 0.f) + (seg < 2 ? s2 : 0.f) + (seg < 1 ? s1 : 0.f); bmid = s3 + s2; }
#pragma unroll
        for (int i = 0; i < 16; ++i) { const int tn = dir ? 16 * seg + 15 - i : 16 * seg + i;
            const float bc = off + c[i];
            const float qe = qs[i] * fexp(bc - bmid), ke = kk[i] * fexp(bmid - bc), qi = qs[i] * fexp(bc);
            const unsigned pk = cvt_pk_bf16(qe, ke);
            *(LAS unsigned short*)(QE + tn * 272 + kd * 2) = (unsigned short)(pk & 0xffffu);
            *(LAS unsigned short*)(KE + tn * 272 + kd * 2) = (unsigned short)(pk >> 16);
            *(LAS unsigned short*)(QI + tn * 272 + kd * 2) = (unsigned short)(cvt_pk_bf16(qi, 0.f) & 0xffffu); }
        BAR_LDS();
        bf16x8 Bq[4];
#pragma unroll
        for (int kb = 0; kb < 4; ++kb) Bq[kb] = *(const LAS bf16x8*)(QE + (tt * 16 + fr) * 272 + (kb * 32 + g * 8) * 2);
        f32x4 att[4];
#pragma unroll
        for (int st = 0; st < 4; ++st) {
            f32x4 a = (f32x4){0.f, 0.f, 0.f, 0.f};
#pragma unroll
            for (int kb = 0; kb < 4; ++kb) { const bf16x8 Ak = *(const LAS bf16x8*)(KE + (st * 16 + fr) * 272 + (kb * 32 + g * 8) * 2);
                a = __builtin_amdgcn_mfma_f32_16x16x32_bf16(Ak, Bq[kb], a, 0, 0, 0); }
            const int t = tt * 16 + fr;
#pragma unroll
            for (int j = 0; j < 4; ++j) { const int sx = st * 16 + g * 4 + j; const bool keep = dir ? (sx >= t) : (sx <= t); a[j] = keep ? a[j] : 0.f; }
            att[st] = a;
        }
        bf16x8 Pb[2];
#pragma unroll
        for (int cp = 0; cp < 2; ++cp) { u32x4 pk; pk.x = cvt_pk_bf16(att[2 * cp][0], att[2 * cp][1]); pk.y = cvt_pk_bf16(att[2 * cp][2], att[2 * cp][3]);
            pk.z = cvt_pk_bf16(att[2 * cp + 1][0], att[2 * cp + 1][1]); pk.w = cvt_pk_bf16(att[2 * cp + 1][2], att[2 * cp + 1][3]); Pb[cp] = __builtin_bit_cast(bf16x8, pk); }
#pragma unroll
        for (int kb = 0; kb < 4; ++kb) Bq[kb] = *(const LAS bf16x8*)(QI + (tt * 16 + fr) * 272 + (kb * 32 + g * 8) * 2);
#pragma unroll
        for (int vt = 0; vt < 4; ++vt) {
            const int vd = (vh * 4 + vt) * 16 + fr;
#pragma unroll
            for (int cp = 0; cp < 2; ++cp) {
                const LAS unsigned char* vp = VT + vd * 144 + (cp * 32 + g * 4) * 2;
                const u32x2 lo = *(const LAS u32x2*)vp, hi = *(const LAS u32x2*)(vp + 32);
                const bf16x8 Av = __builtin_bit_cast(bf16x8, (u32x4){lo.x, lo.y, hi.x, hi.y});
                O[vt] = __builtin_amdgcn_mfma_f32_16x16x32_bf16(Av, Pb[cp], O[vt], 0, 0, 0);
            }
#pragma unroll
            for (int kb = 0; kb < 4; ++kb) O[vt] = __builtin_amdgcn_mfma_f32_16x16x32_bf16(As[vt][kb], Bq[kb], O[vt], 0, 0, 0);
        }
        if (dir == 1) {
            const size_t orow = row0 + tt * 16 + fr;
            u32x2 gp[4];
#pragma unroll
            for (int vt = 0; vt < 4; ++vt) gp[vt] = *(const u32x2*)(proj + 7 * PLANE + ((size_t)h * MT + orow) * 128 + (vh * 4 + vt) * 16 + g * 4);
            float ss = 0.f;
#pragma unroll
            for (int vt = 0; vt < 4; ++vt) ss += (O[vt][0] * O[vt][0] + O[vt][1] * O[vt][1]) + (O[vt][2] * O[vt][2] + O[vt][3] * O[vt][3]);
            ss = xg_sum(ss);
            if (g == 0) RED[vh * 64 + tt * 16 + fr] = ss;
            BAR_LDS();
            const float tot = RED[tt * 16 + fr] + RED[64 + tt * 16 + fr];
            const float rs = __builtin_amdgcn_rsqf(tot * (1.0f / 128.0f) + EPS);
#pragma unroll
            for (int vt = 0; vt < 4; ++vt) {
                const int vd0 = (vh * 4 + vt) * 16 + g * 4;
                const f32x4 nw = *(const f32x4*)(hnw + h * 128 + vd0);
                const float g0 = bf2f(gp[vt].x & 0xffffu), g1 = bf2f(gp[vt].x >> 16), g2 = bf2f(gp[vt].y & 0xffffu), g3 = bf2f(gp[vt].y >> 16);
                u32x2 w; w.x = cvt_pk_bf16(O[vt][0] * rs * nw[0] * g0, O[vt][1] * rs * nw[1] * g1);
                w.y = cvt_pk_bf16(O[vt][2] * rs * nw[2] * g2, O[vt][3] * rs * nw[3] * g3);
                *(u32x2*)(mix + orow * D + 512 + h * 128 + vd0) = w;
            }
        }
        BAR_LDS();
    }
}

__device__ __forceinline__ void ctx_proj_unit(LAS unsigned char* lds, const float* __restrict__ ctx, const float* __restrict__ nw, const float* __restrict__ modc, const bf16_t* __restrict__ WIN,
                                              const float* __restrict__ lbl, bf16_t* __restrict__ proj, int unit, int tid) {
    constexpr int AST = 2064;
    const int lane = tid & 63, wid = tid >> 6, fr = lane & 15, g = lane >> 4;
    const int rb = unit / 20, gq = unit % 20, gsel = gq >> 2, cb = gq & 3;
    const int gidx = gsel == 0 ? 1 : gsel == 1 ? 2 : gsel + 2;
#pragma unroll 1
    for (int rq = 0; rq < 2; ++rq) {
        f32x4 v[4][4]; float s[4];
#pragma unroll
        for (int rr = 0; rr < 4; ++rr) { const float* xrow = ctx + (size_t)(rb * 64 + wid * 8 + rq * 4 + rr) * D; s[rr] = 0.f;
#pragma unroll
            for (int j = 0; j < 4; ++j) v[rr][j] = *(const f32x4*)(xrow + 4 * lane + 256 * j); }
#pragma unroll
        for (int rr = 0; rr < 4; ++rr) {
#pragma unroll
            for (int j = 0; j < 4; ++j) s[rr] += (v[rr][j].x * v[rr][j].x + v[rr][j].y * v[rr][j].y) + (v[rr][j].z * v[rr][j].z + v[rr][j].w * v[rr][j].w);
            const float r = __builtin_amdgcn_rsqf(wave_sum(s[rr]) * (1.f / D) + EPS); const int lr = wid * 8 + rq * 4 + rr;
#pragma unroll
            for (int j = 0; j < 4; ++j) { const int c = 4 * lane + 256 * j;
                const f32x4 ww = *(const f32x4*)(nw + c), sh = *(const f32x4*)(modc + c), sc = *(const f32x4*)(modc + 1024 + c);
                const f32x4 y = v[rr][j] * r * ww * (sc + 1.0f) + sh;
                u32x2 o; o.x = cvt_pk_bf16(y.x, y.y); o.y = cvt_pk_bf16(y.z, y.w);
                *(LAS u32x2*)(lds + lr * AST + c * 2) = o; }
        }
    }
    __syncthreads();
    const int cg0 = cb * 128 + wid * 16;
    const bf16_t* wrow = WIN + (size_t)(gidx * 512 + cg0 + fr) * D + g * 8;
    f32x4 acc[4];
#pragma unroll
    for (int rt = 0; rt < 4; ++rt) acc[rt] = (f32x4){0.f, 0.f, 0.f, 0.f};
#pragma unroll 16
    for (int ks = 0; ks < 32; ++ks) {
        const bf16x8 Bw = *(const bf16x8*)(wrow + ks * 32);
#pragma unroll
        for (int rt = 0; rt < 4; ++rt) { const bf16x8 Aa = *(const LAS bf16x8*)(lds + (rt * 16 + fr) * AST + (ks * 32 + g * 8) * 2);
            acc[rt] = __builtin_amdgcn_mfma_f32_16x16x32_bf16(Aa, Bw, acc[rt], 0, 0, 0); }
    }
    const int cg = cg0 + fr, hd = gidx < 3 ? 64 : 128, h = gidx < 3 ? (cg >> 6) : (cg >> 7), d = cg & (hd - 1);
    float lb = 0.f;
    if (gidx == 4 || gidx == 5) { const int k = (gidx - 4) * 512 + cg; lb = 1.0f / (1.0f + expf(lbl[1024 + k] - lbl[k])); }
    bf16_t* base = proj + (size_t)gidx * PLANE;
#pragma unroll
    for (int rt = 0; rt < 4; ++rt) {
        const int row = M + rb * 64 + rt * 16 + g * 4;
        float v[4];
#pragma unroll
        for (int j = 0; j < 4; ++j) { v[j] = acc[rt][j]; if (gidx == 4 || gidx == 5) v[j] = flog(lb + (1.0f - lb) * fsigmoid(v[j])); }
        if (gidx == 2) { u32x2 w; w.x = cvt_pk_bf16(v[0], v[1]); w.y = cvt_pk_bf16(v[2], v[3]);
            *(u32x2*)(base + ((size_t)h * MT + (row & ~63) + d) * 64 + (row & 63)) = w; }
        else {
#pragma unroll
            for (int j = 0; j < 4; ++j) base[((size_t)h * MT + row + j) * hd + d] = (bf16_t)(cvt_pk_bf16(v[j], 0.f) & 0xffffu);
        }
    }
    __syncthreads();
}

constexpr int NPHASE = 15;
__global__ void __launch_bounds__(512, 2) fwd_kernel(Args a) {
    extern __shared__ __attribute__((aligned(16))) unsigned char lds_raw[];
    LAS unsigned char* lds = (LAS unsigned char*)lds_raw;
    const int tid = threadIdx.x, lane = tid & 63, wid = __builtin_amdgcn_readfirstlane(tid >> 6);
    const int G = gridDim.x, bid = blockIdx.x;
    const int gw = bid * 8 + wid, NGW = G * 8;
    unsigned char* ws = a.ws;
    float* MOD = (float*)(ws + WS_MOD); float* MODC = MOD + 2 * 2 * 6144;
    float* SBUP = (float*)(ws + WS_SB); float* SBOD = SBUP + 2 * 2 * 2 * DFF;
    float* SSQ = (float*)(ws + WS_SSQ);
    float* HDEC = (float*)(ws + WS_HDEC);
    bf16_t* HKVC = (bf16_t*)(ws + WS_HKVC);
    bf16_t* WIN = (bf16_t*)(ws + WS_WIN); bf16_t* WOUT = (bf16_t*)(ws + WS_WOUT); bf16_t* ODIN = (bf16_t*)(ws + WS_ODIN); bf16_t* ODOUT = (bf16_t*)(ws + WS_ODOUT);
    bf16_t* UP = (bf16_t*)(ws + WS_UP); bf16_t* DOWN = (bf16_t*)(ws + WS_DOWN);
    bf16_t* HA = (bf16_t*)(ws + WS_HA) + (size_t)256 * D;
    bf16_t* PROJ = (bf16_t*)(ws + WS_PROJ); bf16_t* TB = PROJ; bf16_t* PB = PROJ;
    bf16_t* MIX = (bf16_t*)(ws + WS_MIX); bf16_t* ZB = MIX;
    bf16_t* XB = (bf16_t*)(ws + WS_PROJ + 96 * MiB);
    bf16_t* STATE = (bf16_t*)a.out;
    const int lo = a.ph_lo, hi = a.ph_hi;
    volatile LAS unsigned* bst = (volatile LAS unsigned*)(lds + LDS_BYTES - 16);
    if (tid < 4) bst[tid] = 0u;
    __syncthreads();
    XcdBarrier xbar; xbar.bar = (unsigned*)(ws + WS_BAR); xbar.x = 0; xbar.st = bst;
    if (hi - lo > 1) {
        if (lo < 0) cg::this_grid().sync();
        xbar = xcd_barrier_post((unsigned*)(ws + WS_BAR), bst);
    }
#ifndef PH_MASK
#define PH_MASK 0x7fff
#endif
#define IN(k) (((PH_MASK >> (k)) & 1) && lo <= (k) && (k) < hi)
#define SEAM(k) do { if (IN(k) && IN((k) + 1)) xcd_barrier(xbar); } while (0)

    if (IN(0)) {
        LAS float* scr = (LAS float*)(lds + wid * 16384);
        constexpr int I_WIN = 16 * 128, I_WOUT = 16 * 32, I_UP = 16 * 176, I_DOWN = 44 * 32;
        constexpr int I_ODOUT = 16 * 32, NIT = I_WIN + I_WOUT + I_UP + I_DOWN + I_ODOUT;
        const bool bal = (G == 256);
        const int ibase = bal ? (bid < 192 ? bid * 23 : 4416 + (bid - 192) * 45) : gw, iend = bal ? ibase + (bid < 192 ? 23 : 45) : NIT, istep = bal ? 8 : NGW;
        static_assert(192 * 23 + 64 * 45 == NIT, "transpose item split");
        for (int it = ibase + (bal ? wid : 0); it < iend; it += istep) {
            int r = it;
            if (r < I_WIN) { transpose_item<0, false>(a.ev_w_in, D, EVN, WIN, scr, r, lane); continue; } r -= I_WIN;
            if (r < I_WOUT) { transpose_item<0, false>(a.ev_w_out, D, D, WOUT, scr, r, lane); continue; } r -= I_WOUT;
            if (r < I_UP) { transpose_item<1, false>(a.ffn_w_up, D, 2 * DFF, UP, scr, r, lane); continue; } r -= I_UP;
            if (r < I_DOWN) { transpose_item<0, false>(a.ffn_w_down, DFF, D, DOWN, scr, r, lane); continue; } r -= I_DOWN;
            transpose_item<0, false>(a.od_w_out, D, D, ODOUT, scr, r, lane);
        }
        __syncthreads();
        LAS float* sv = (LAS float*)lds;
        LAS float* red = (LAS float*)(lds + 16384);
        for (int i = tid; i < 1024; i += 512) { sv[i] = a.c[i] / (1.0f + expf(-a.c[i])); sv[1024 + i] = a.c[1024 + i] / (1.0f + expf(-a.c[1024 + i])); sv[2048 + i] = a.c_ctx[i] / (1.0f + expf(-a.c_ctx[i])); }
        __syncthreads();
        for (int it = bid; it < 192; it += G) {
            const int l = it / 96, cc = it % 96, kg = tid >> 4, c4 = tid & 15;
            const float* Wp = a.ada_w + (size_t)l * D * 6144 + cc * 64 + c4 * 4;
            f32x4 a0 = (f32x4){0.f, 0.f, 0.f, 0.f}, a1 = a0, a2 = a0;
#pragma unroll 8
            for (int k = 0; k < 32; ++k) { const int kk = kg * 32 + k; const f32x4 w = __builtin_nontemporal_load((const f32x4*)(Wp + (size_t)kk * 6144));
                a0 += w * sv[kk]; a1 += w * sv[1024 + kk]; a2 += w * sv[2048 + kk]; }
            *(LAS f32x4*)(red + (kg * 3 + 0) * 64 + c4 * 4) = a0; *(LAS f32x4*)(red + (kg * 3 + 1) * 64 + c4 * 4) = a1; *(LAS f32x4*)(red + (kg * 3 + 2) * 64 + c4 * 4) = a2;
            __syncthreads();
            if (tid < 192) { const int v = tid / 64, col = tid % 64; float s = 0.f;
#pragma unroll 8
                for (int k = 0; k < 32; ++k) s += red[(k * 3 + v) * 64 + col];
                s += a.ada_b[l * 6144 + cc * 64 + col];
                if (v < 2) MOD[(l * 2 + v) * 6144 + cc * 64 + col] = s; else if (l == 0) MODC[cc * 64 + col] = s; }
            __syncthreads();
        }
    }
    SEAM(0);
    if (IN(1)) {
        for (int u = bid; u < 160; u += G) ctx_proj_unit(lds, a.ctx, a.norm_mix_w, MODC, WIN, a.hg_lb, PROJ, u, tid);
        for (int r = 2 * gw; r < M; r += 2 * NGW) norm_mod_row2(a.x + (size_t)r * D, a.x + (size_t)(r + 1) * D, a.norm_mix_w, MOD + (size_t)(r >> 13) * 6144, MOD + (size_t)(r >> 13) * 6144 + 1024, HA + (size_t)r * D, HA + (size_t)(r + 1) * D, lane);
        for (int r = gw; r < 2 * DFF; r += NGW) {
            const bf16_t* wrow; const float* sh; float* dst;
            if (r < 2 * 2 * DFF) { const int l = r / (2 * DFF), n = r % (2 * DFF); wrow = UP + (size_t)r * D; sh = MOD + (size_t)l * 2 * 6144 + 3072; dst = SBUP + (size_t)l * 2 * 2 * DFF + n; }
            else { const int n = r - 2 * 2 * DFF; wrow = ODIN + (size_t)n * D; sh = MOD + (size_t)2 * 6144; dst = SBOD + n; }
            const int dstride = (r < 2 * 2 * DFF) ? 2 * DFF : 3 * D;
            const u32x4 w0 = *(const u32x4*)(wrow + lane * 16), w1 = *(const u32x4*)(wrow + lane * 16 + 8);
            float s0 = 0.f, s1 = 0.f;
#pragma unroll
            for (int e = 0; e < 8; ++e) { const unsigned wa = w0[e >> 1], wb = w1[e >> 1];
                const float fa = bf2f((e & 1) ? (wa >> 16) : (wa & 0xffffu)), fb = bf2f((e & 1) ? (wb >> 16) : (wb & 0xffffu));
                s0 += fa * sh[lane * 16 + e] + fb * sh[lane * 16 + 8 + e]; s1 += fa * sh[6144 + lane * 16 + e] + fb * sh[6144 + lane * 16 + 8 + e]; }
            s0 = wave_sum(s0); s1 = wave_sum(s1);
            if (lane == 0) { dst[0] = s0; dst[dstride] = s1; }
        }
    }
    SEAM(1);
    if (IN(2)) {
        pg8::Gemm g{HA, WIN, D}; pg8::StaticOrder<false> S; S.init(M / 256, EVN / 256, G, bid);
        pg8::EpiProj E{PROJ, a.hg_lb};
        for (int rep = 0; rep < DUP2; ++rep) pg8::gemm_phase(lds, g, S, E);
    }
    SEAM(2);
    if (IN(3)) {
      for (int rep = 0; rep < DUP3; ++rep) {
#ifndef NO_NA
        for (int rep2 = 0; rep2 < DUPNA; ++rep2) for (int it = bid; it < 256; it += G) na_item(lds, PROJ, a.na_rpb, MIX, it, wid, lane);
#endif
        __syncthreads();
        for (int rep2 = 0; rep2 < DUPPA; ++rep2) { hg_passA_phase(lds, PROJ, a.hg_lb, STATE, HKVC, HDEC, bid, G, tid); __syncthreads(); }
        __syncthreads();
      }
    }
    SEAM(3);
    if (IN(4)) {
        for (int gid = bid * 512 + tid; gid < NCHAIN * 8192; gid += G * 512) {
            const int chain = gid >> 13, e = gid & 8191, vd = e >> 6, kp = e & 63;
            const float* dec = HDEC + (size_t)chain * NCHT * 128 + 2 * kp;
            float S0 = 0.f, S1 = 0.f;
            const unsigned* kvc = (const unsigned*)(HKVC + (size_t)chain * 4 * 16384) + vd * 64 + kp;
#pragma unroll
            for (int ci = 0; ci < 4; ++ci) { const unsigned kv = kvc[(size_t)ci * 8192]; const f32x2 d = *(const f32x2*)(dec + ci * 128);
                S0 = d.x * S0 + bf2f(kv & 0xffffu); S1 = d.y * S1 + bf2f(kv >> 16); }
            unsigned* st = (unsigned*)(STATE + (size_t)chain * NCH * 16384) + vd * 64 + kp;
#pragma unroll 1
            for (int j0 = 0; j0 < NCH; j0 += 16) {
                unsigned kv[16]; f32x2 dd[16];
#pragma unroll
                for (int k = 0; k < 16; ++k) { kv[k] = (j0 + k < NCH - 1) ? st[(size_t)(j0 + k) * 8192] : 0u; dd[k] = *(const f32x2*)(dec + (4 + j0 + k) * 128); }
#pragma unroll
                for (int k = 0; k < 16; ++k) {
                    st[(size_t)(j0 + k) * 8192] = cvt_pk_bf16(S0, S1);
                    S0 = dd[k].x * S0 + bf2f(kv[k] & 0xffffu); S1 = dd[k].y * S1 + bf2f(kv[k] >> 16);
                }
            }
        }
    }
    SEAM(4);
    if (IN(5)) {
      for (int rep = 0; rep < DUP5; ++rep) hg_passC_phase(lds, PROJ, a.hg_lb, a.hg_norm_w, STATE, MIX, bid, G, tid);
    }
    SEAM(5);
    if (IN(6)) {
        pg8::Gemm g{MIX, WOUT, D}; pg8::StaticOrder<false> S; S.init(M / 256, D / 256, G, bid);
        pg8::EpiResidB<true> E{a.x, nullptr, nullptr, MOD + 2048, HA, a.norm_ffn_w, MOD + 4096, SSQ};
        pg8::gemm_phase(lds, g, S, E);
    }
    SEAM(6);
    if (IN(7)) {
        pg8::Gemm g{HA, UP, D}; pg8::StaticOrder<true> S; S.init(66, 22, G, bid);
        pg8::EpiConvGlu E{TB, a.ffn_conv_w, a.ffn_conv_b, (LAS float*)(lds + XCH_OFF), SSQ, SBUP};
        pg8::gemm_phase(lds, g, S, E);
        {
            constexpr int J_ODIN = 16 * 96, J_UP = 16 * 176, NJ = J_ODIN + J_UP;
            const bool idle = (G == 256);
            const int w0 = idle ? (bid - 172) * 8 + wid : gw, nW = idle ? 84 * 8 : NGW;
            if (!idle || bid >= 172) {
                LAS float* scr = (LAS float*)(lds + wid * 16384);
                LAS float* shl = (LAS float*)(lds + 8 * 16384);
                for (int i = tid; i < 1024; i += 512) { shl[i] = MOD[2 * 6144 + i]; shl[1024 + i] = MOD[3 * 6144 + i]; shl[2048 + i] = MOD[2 * 6144 + 3072 + i]; shl[3072 + i] = MOD[3 * 6144 + 3072 + i]; }
                __syncthreads();
                for (int it = w0; it < NJ; it += nW) {
                    int r = it;
                    if (r < J_UP) { transpose_item<1, true>(a.ffn_w_up + (size_t)D * 2 * DFF, D, 2 * DFF, UP + (size_t)2 * DFF * D, scr, r, lane, shl + 2048, SBUP + (size_t)2 * 2 * DFF, 2 * DFF); continue; } r -= J_UP;
                    transpose_item<2, true>(a.od_w_in, D, 3 * D, ODIN, scr, r, lane, shl, SBOD, 3 * D);
                }
                __syncthreads();
            }
        }
    }
    SEAM(7);
    if (IN(8)) {
        pg8::Gemm g{TB, DOWN, DFF}; pg8::StaticOrder<false> S; S.init(M / 256, D / 256, G, bid);
        pg8::EpiResidB<false> E{HA, a.norm_ffn_w, MOD + 4096, MOD + 5120, HA, a.norm_mix_w + D, MOD + 2 * 6144 + 1024, SSQ + M};
        pg8::gemm_phase(lds, g, S, E);
    }
    SEAM(8);
    if (IN(9)) {
        pg8::Gemm g{HA, ODIN, D}; pg8::StaticOrder<false> S; S.init(M / 256, 8, G, bid);
        pg8::EpiMulPair E{PB, SSQ + M, SBOD};
        pg8::gemm_phase(lds, g, S, E);
    }
    SEAM(9);
    if (IN(10)) {
        pg8::Gemm g{HA, ODIN + (size_t)2048 * D, D}; pg8::StaticOrder<false> S; S.init(M / 256, 4, G, bid);
        pg8::EpiGateConv E{PB, ZB, a.od_conv_w, a.od_conv_b, SSQ + M, SBOD};
        pg8::gemm_phase(lds, g, S, E);
    }
    SEAM(10);
    if (IN(11)) {
        pg8::Gemm g{ZB, ODOUT, D}; pg8::StaticOrder<false> S; S.init(M / 256, D / 256, G, bid);
        pg8::EpiResidB<false> E{HA, a.norm_mix_w + D, MOD + 2 * 6144 + 1024, MOD + 2 * 6144 + 2048, HA, a.norm_ffn_w + D, MOD + 2 * 6144 + 4096, SSQ + 2 * M};
        pg8::gemm_phase(lds, g, S, E);
    }
    SEAM(11);
    if (IN(12)) {
        pg8::Gemm g{HA, UP + (size_t)2 * DFF * D, D}; pg8::StaticOrder<true> S; S.init(66, 22, G, bid);
        pg8::EpiConvGlu E{TB, a.ffn_conv_w + 3 * DFF, a.ffn_conv_b + DFF, (LAS float*)(lds + XCH_OFF), SSQ + 2 * M, SBUP + 2 * 2 * DFF};
        pg8::gemm_phase(lds, g, S, E);
        {
            const bool idle = (G == 256);
            const int w0 = idle ? (bid - 172) * 8 + wid : gw, nW = idle ? 84 * 8 : NGW;
            if (!idle || bid >= 172) { LAS float* scr = (LAS float*)(lds + wid * 16384);
                for (int it = w0; it < 44 * 32; it += nW) transpose_item<0, false>(a.ffn_w_down + (size_t)DFF * D, DFF, D, DOWN + (size_t)D * DFF, scr, it, lane); }
        }
    }
    SEAM(12);
    const bool fuse_final = (G == 256) && (hi - lo > 1);
    if (IN(13)) {
        pg8::Gemm g{TB, DOWN + (size_t)D * DFF, DFF}; pg8::StaticOrder<false> S; S.init(M / 256, D / 256, G, bid);
        if (fuse_final) { pg8::EpiResidFinal E{HA, a.norm_ffn_w + D, MOD + 2 * 6144 + 4096, a.out, MOD + 2 * 6144 + 5120, a.final_norm_w, (float*)(ws + WS_XS), (unsigned*)(ws + WS_CNT), (LAS float*)(lds + XCH_OFF)}; pg8::gemm_phase(lds, g, S, E); }
        else { pg8::EpiResidOut E{HA, a.norm_ffn_w + D, MOD + 2 * 6144 + 4096, a.out, MOD + 2 * 6144 + 5120}; pg8::gemm_phase(lds, g, S, E); }
    }
    if (!fuse_final) SEAM(13);
    if (IN(14) && !fuse_final) {
        for (int r = gw; r < M; r += NGW) {
            float* xr = a.out + (size_t)r * D;
            f32x4 v[4]; float s = 0.f;
#pragma unroll
            for (int j = 0; j < 4; ++j) { v[j] = *(const f32x4*)(xr + 4 * lane + 256 * j); s += (v[j].x * v[j].x + v[j].y * v[j].y) + (v[j].z * v[j].z + v[j].w * v[j].w); }
            const float rr = __builtin_amdgcn_rsqf(wave_sum(s) * (1.f / D) + EPS);
#pragma unroll
            for (int j = 0; j < 4; ++j) { const f32x4 ww = *(const f32x4*)(a.final_norm_w + 4 * lane + 256 * j); *(f32x4*)(xr + 4 * lane + 256 * j) = v[j] * rr * ww; }
        }
    }
#undef IN
#undef SEAM
}

extern "C" void kernel_launch(void* const* d_in, const int* in_sizes, int n_in, void* d_out, int out_size, void* d_ws, size_t ws_size, hipStream_t stream) {
    static int grid = 0;
    if (grid == 0) {
        int dev = 0, cus = 0, per_cu = 0;
        hipGetDevice(&dev);
        hipDeviceGetAttribute(&cus, hipDeviceAttributeMultiprocessorCount, dev);
        if (hipFuncSetAttribute((const void*)fwd_kernel, hipFuncAttributeMaxDynamicSharedMemorySize, LDS_BYTES) != hipSuccess) fprintf(stderr, "kernel_launch: hipFuncSetAttribute failed\n");
        if (hipOccupancyMaxActiveBlocksPerMultiprocessor(&per_cu, (const void*)fwd_kernel, 512, LDS_BYTES) != hipSuccess || per_cu < 1) { fprintf(stderr, "kernel_launch: occupancy query says %d\n", per_cu); per_cu = 1; }
        (void)hipGetLastError();
        grid = cus > 0 ? cus : 256;
        if (ws_size < WS_END) fprintf(stderr, "kernel_launch: workspace too small (%zu)\n", ws_size);
    }
    Args a{};
    const float** p = (const float**)&a;
    for (int i = 0; i < 22; ++i) p[i] = (const float*)d_in[i];
    a.out = (float*)d_out; a.ws = (unsigned char*)d_ws;
    (void)hipMemsetAsync((char*)d_ws + WS_ZERO_LO, 0, WS_ZERO_BYTES, stream);
#if MK_SINGLE
    a.ph_lo = 0; a.ph_hi = NPHASE;
    void* args[] = {&a};
    hipError_t e = hipLaunchCooperativeKernel((const void*)fwd_kernel, dim3(grid), dim3(512), args, LDS_BYTES, stream);
    if (e != hipSuccess) fprintf(stderr, "cooperative launch failed: %s (grid %d)\n", hipGetErrorString(e), grid);
#else
    for (int ph = 0; ph < NPHASE; ++ph) { a.ph_lo = ph; a.ph_hi = ph + 1; hipLaunchKernelGGL(fwd_kernel, dim3(grid), dim3(512), LDS_BYTES, stream, a); }
#endif
}
```

```cpp
#include <hip/hip_runtime.h>
#include <hip/hip_cooperative_groups.h>
#include <cstdio>
#include <cstdint>
namespace cg = cooperative_groups;

#ifndef DUP7
#define DUP7 1
#endif
#ifndef DUPPA
#define DUPPA 1
#endif
#ifndef DUP2
#define DUP2 1
#endif
#ifndef DUPNA
#define DUPNA 1
#endif
#ifndef DUP3
#define DUP3 1
#endif
#ifndef DUP5
#define DUP5 1
#endif
#ifndef MK_SINGLE
#define MK_SINGLE 1
#endif

#define LAS __attribute__((address_space(3)))
typedef unsigned short bf16_t;
typedef short bf16x8 __attribute__((ext_vector_type(8)));
typedef float f32x4 __attribute__((ext_vector_type(4)));
typedef float f32x2 __attribute__((ext_vector_type(2)));
typedef unsigned u32x4 __attribute__((ext_vector_type(4)));
typedef unsigned u32x2 __attribute__((ext_vector_type(2)));

constexpr int D = 1024, SEQ = 8192, M = 16384, MC = 512, MT = M + MC, CTXL = 256;
constexpr int DFF = 2816, EVN = 4096;
constexpr float EPS = 1e-6f;
constexpr float LOG2E = 1.4426950408889634f, LN2 = 0.6931471805599453f;
constexpr size_t PLANE = (size_t)MT * 512;
constexpr int NCHAIN = 16, NCH = 128, NCHT = 132;

constexpr size_t MiB = 1u << 20;
constexpr size_t WS_MOD = 0;
constexpr size_t WS_SB = 128 * 1024;
constexpr size_t WS_SSQ = 256 * 1024;
constexpr size_t WS_BAR = 512 * 1024;
constexpr size_t WS_CNT = WS_BAR + 16384;
constexpr size_t WS_XS = 640 * 1024;
constexpr size_t WS_ZERO_LO = WS_SB, WS_ZERO_BYTES = WS_CNT + 16384 - WS_SB;
constexpr size_t WS_HDEC = 1 * MiB;
constexpr size_t WS_HKVC = 3 * MiB;
constexpr size_t WS_WIN = 5 * MiB;
constexpr size_t WS_WOUT = 13 * MiB;
constexpr size_t WS_ODIN = 15 * MiB;
constexpr size_t WS_ODOUT = 21 * MiB;
constexpr size_t WS_UP = 23 * MiB;
constexpr size_t WS_DOWN = 45 * MiB;
constexpr size_t WS_HA = 56 * MiB;
constexpr size_t WS_PROJ = 90 * MiB;
constexpr size_t WS_MIX = 222 * MiB;
constexpr size_t WS_END = 254 * MiB;

constexpr int STAGE_BYTES = 131072;
constexpr int XCH_OFF = STAGE_BYTES;
constexpr int NA_WAVE_BYTES = 19280;
constexpr int LDS_BYTES = 152 * 1024;
static_assert(8 * NA_WAVE_BYTES <= LDS_BYTES && XCH_OFF + 4096 <= LDS_BYTES, "lds");

__device__ __forceinline__ float bf2f(unsigned h) { return __builtin_bit_cast(float, h << 16); }
typedef __bf16 bf16x2_t __attribute__((ext_vector_type(2)));
__device__ __forceinline__ unsigned cvt_pk_bf16(float lo, float hi) { const f32x2 v = {lo, hi}; const bf16x2_t b = __builtin_convertvector(v, bf16x2_t); return __builtin_bit_cast(unsigned, b); }
__device__ __forceinline__ float fexp2(float x) { return __builtin_amdgcn_exp2f(x); }
__device__ __forceinline__ float fexp(float x) { return __builtin_amdgcn_exp2f(x * LOG2E); }
__device__ __forceinline__ float flog(float x) { return __builtin_amdgcn_logf(x) * LN2; }
__device__ __forceinline__ float frcp(float x) { return __builtin_amdgcn_rcpf(x); }
__device__ __forceinline__ float fsigmoid(float x) { return frcp(1.0f + fexp(-x)); }
__device__ __forceinline__ float fsilu(float x) { return x * fsigmoid(x); }
#define LDS_WAIT() asm volatile("s_waitcnt lgkmcnt(0)" ::: "memory")
__device__ __forceinline__ float wave_sum(float v) {
#pragma unroll
    for (int o = 1; o < 64; o <<= 1) v += __shfl_xor(v, o);
    return v;
}
__device__ __forceinline__ float xg_max(float x) {
    const unsigned u = __builtin_bit_cast(unsigned, x);
    const auto r = __builtin_amdgcn_permlane16_swap(u, u, false, false);
    const float m = fmaxf(__builtin_bit_cast(float, (unsigned)r[0]), __builtin_bit_cast(float, (unsigned)r[1]));
    const unsigned v = __builtin_bit_cast(unsigned, m);
    const auto q = __builtin_amdgcn_permlane32_swap(v, v, false, false);
    return fmaxf(__builtin_bit_cast(float, (unsigned)q[0]), __builtin_bit_cast(float, (unsigned)q[1]));
}
__device__ __forceinline__ float xg_sum(float x) {
    const unsigned u = __builtin_bit_cast(unsigned, x);
    const auto r = __builtin_amdgcn_permlane16_swap(u, u, false, false);
    const float m = __builtin_bit_cast(float, (unsigned)r[0]) + __builtin_bit_cast(float, (unsigned)r[1]);
    const unsigned v = __builtin_bit_cast(unsigned, m);
    const auto q = __builtin_amdgcn_permlane32_swap(v, v, false, false);
    return __builtin_bit_cast(float, (unsigned)q[0]) + __builtin_bit_cast(float, (unsigned)q[1]);
}
template <int CTRL> __device__ __forceinline__ float dppf(float old, float src) {
    return __builtin_bit_cast(float, __builtin_amdgcn_update_dpp(__builtin_bit_cast(int, old), __builtin_bit_cast(int, src), CTRL, 0xF, 0xF, false));
}
__device__ __forceinline__ f32x2 gelu_pk(f32x2 v) {
    const f32x2 av = __builtin_elementwise_abs(v), d = av * 0.2316418882f + 1.0f;
    f32x2 t; t.x = __builtin_amdgcn_rcpf(d.x); t.y = __builtin_amdgcn_rcpf(d.y);
    f32x2 q = t * 0.5307027145f + (-0.7265760135f); q = q * t + 0.7107068705f; q = q * t + (-0.142248368f); q = q * t + 0.127414796f; q = q * t;
    const f32x2 s = (v * v) * (-0.72134752044f);
    f32x2 e; e.x = __builtin_amdgcn_exp2f(s.x); e.y = __builtin_amdgcn_exp2f(s.y);
    const f32x2 m = v * (q * e), r = v - m;
    f32x2 o; o.x = v.x < 0.f ? m.x : r.x; o.y = v.y < 0.f ? m.y : r.y; return o;
}

namespace pg8 {
constexpr int BM = 256, BK = 64, HALF = 128, HTB = HALF * BK * 2, NXCD = 8, WGM = 8;
__host__ __device__ __forceinline__ int lds_byte(int r, int c) { const int st = (r >> 4) * 2 + (c >> 5), rr = r & 15, cc = c & 31, ob = rr * 64 + cc * 2; return st * 1024 + (ob ^ (((ob >> 9) & 1) << 5)); }
__host__ __device__ __forceinline__ void stage_rc(int b, int& R, int& C) { const int st = b / 1024, sb = b % 1024, swz = sb ^ (((sb >> 9) & 1) << 5); R = (st >> 1) * 16 + swz / 64; C = (st & 1) * 32 + (swz % 64) / 2; }
__host__ __device__ __forceinline__ int perm32(int rho) { const int n = rho >> 4, i = rho & 15; return 8 * (i >> 2) + 4 * n + (i & 3); }

struct Unit { int pm, pn, arow; };
struct Gemm { const bf16_t* A; const bf16_t* Bt; int K; };

template <bool OVL> struct StaticOrder {
    int nM, nN, nwg, G, c;
    __device__ void init(int nM_, int nN_, int G_, int c_) { nM = nM_; nN = nN_; nwg = nM * nN; G = G_; c = c_; }
    __device__ bool next(int i, Unit& u) const {
        const long L = (long)i * G + c; if (L >= nwg) return false;
        int wgid = (int)L; { const int q = nwg / NXCD, r = nwg % NXCD, xcd = wgid % NXCD, off = wgid / NXCD; wgid = (xcd < r ? xcd * (q + 1) : r * (q + 1) + (xcd - r) * q) + off; }
        const int nig = WGM * nN, gid = wgid / nig, fm = gid * WGM, gsz = (nM - fm) < WGM ? (nM - fm) : WGM;
        u.pm = fm + ((wgid % nig) % gsz); u.pn = (wgid % nig) / gsz;
        if (OVL) { const int b = u.pm / 33, ti = u.pm % 33; u.arow = b * SEQ + 254 * ti - 1; } else u.arow = u.pm * BM;
        return true;
    }
};

template <class Epi, class Sched>
__device__ __forceinline__ void gemm_phase(LAS unsigned char* lds, const Gemm g, const Sched& S, const Epi& E) {
    const int tid = threadIdx.x, wid = __builtin_amdgcn_readfirstlane(tid >> 6), lane = tid & 63, wr = wid >> 2, wc = wid & 3, fr = lane & 15, fq = lane >> 4;
    const int K = g.K, nt = K / BK;
    unsigned voffA[2], voffB[2];
#pragma unroll
    for (int i = 0; i < 2; ++i) { int R, C; stage_rc(tid * 16 + i * 8192, R, C); const int Rb = (R & ~31) + perm32(R & 31);
        voffA[i] = (unsigned)(R * K + C) * 2u; voffB[i] = (unsigned)(Rb * K + C) * 2u; }
    const size_t kstep = (size_t)(BK * 2);
    const size_t hstep = (size_t)HALF * K * 2;
    const size_t tstep = 2 * hstep;
    const size_t rstep = (size_t)K * 2;
    const unsigned ldsw = (unsigned)wid * 1024u;
    const int aoff = lds_byte(wr * 64 + fr, fq * 8), boff = lds_byte(wc * 32 + fr, fq * 8);
#define PG8_SA(b, h) (((b) * 2 + (h)) * HTB)
#define PG8_SB(b, h) ((4 + (b) * 2 + (h)) * HTB)
#define PG8_STAGE(bufoff, gbase, voff) do { _Pragma("unroll") for (int _i = 0; _i < 2; ++_i) \
        __builtin_amdgcn_global_load_lds((const unsigned*)((const char*)(gbase) + (voff)[_i]), (LAS unsigned*)(lds + (bufoff) + ldsw + _i * 8192), 16, 0, 0); } while (0)
#define PG8_LDA(dst, b, h) do { _Pragma("unroll") for (int m = 0; m < 4; ++m) _Pragma("unroll") for (int k = 0; k < 2; ++k) dst[m][k] = *(const LAS bf16x8*)(lds + PG8_SA(b, h) + aoff + m * 2048 + k * 1024); } while (0)
#define PG8_LDB(dst, b, h) do { _Pragma("unroll") for (int n = 0; n < 2; ++n) _Pragma("unroll") for (int k = 0; k < 2; ++k) dst[n][k] = *(const LAS bf16x8*)(lds + PG8_SB(b, h) + boff + n * 2048 + k * 1024); } while (0)
#define PG8_MMA(ai, bj, At, Bt) do { __builtin_amdgcn_s_setprio(1); _Pragma("unroll") for (int m = 0; m < 4; ++m) _Pragma("unroll") for (int n = 0; n < 2; ++n) _Pragma("unroll") for (int k = 0; k < 2; ++k) \
        acc[ai][bj][m][n] = __builtin_amdgcn_mfma_f32_16x16x32_bf16(Bt[n][k], At[m][k], acc[ai][bj][m][n], 0, 0, 0); __builtin_amdgcn_s_setprio(0); } while (0)
#define PG8_WAIT_V(n) asm volatile("s_waitcnt vmcnt(" #n ")" ::: "memory")
#define PG8_WAIT_L(n) asm volatile("s_waitcnt lgkmcnt(" #n ")" ::: "memory")
#define PG8_BAR __builtin_amdgcn_s_barrier()
#define PG8_SCHED __builtin_amdgcn_sched_barrier(0)
    Unit cur, nxt; int ui = 0;
    if (!S.next(0, cur)) return;
    f32x4 acc[2][2][4][2];
#pragma unroll
    for (int a = 0; a < 2; ++a)
#pragma unroll
        for (int b = 0; b < 2; ++b)
#pragma unroll
            for (int m = 0; m < 4; ++m)
#pragma unroll
                for (int n = 0; n < 2; ++n) acc[a][b][m][n] = (f32x4){0.f, 0.f, 0.f, 0.f};
    bf16x8 At[4][2], B0[2][2], B1[2][2];
    const char* cA = (const char*)g.A + (long)cur.arow * (long)rstep; const char* cB = (const char*)g.Bt + (size_t)cur.pn * tstep;
    PG8_STAGE(PG8_SB(0, 0), cB, voffB); PG8_STAGE(PG8_SB(0, 1), cB + hstep, voffB); PG8_STAGE(PG8_SA(0, 0), cA, voffA); PG8_STAGE(PG8_SA(0, 1), cA + hstep, voffA);
    if (wr == 1) PG8_BAR;
    PG8_WAIT_V(2); PG8_BAR;
    PG8_STAGE(PG8_SB(1, 0), cB + kstep, voffB); PG8_STAGE(PG8_SA(1, 0), cA + kstep, voffA); PG8_STAGE(PG8_SB(1, 1), cB + hstep + kstep, voffB);
    PG8_WAIT_V(6); PG8_BAR;
    for (;;) {
        const bool has_next = S.next(ui + 1, nxt);
        const char* nA = has_next ? (const char*)g.A + (long)nxt.arow * (long)rstep : cA; const char* nB = has_next ? (const char*)g.Bt + (size_t)nxt.pn * tstep : cB;
        for (int t = 0; t < nt; t += 2) {
            const bool last = (t == nt - 2);
            const char* a1 = cA + (size_t)(t + 1) * kstep;
            const char* a2 = last ? nA : cA + (size_t)(t + 2) * kstep; const char* b2 = last ? nB : cB + (size_t)(t + 2) * kstep;
            const char* a3 = a2 + kstep; const char* b3 = b2 + kstep;
            PG8_LDB(B0, 0, 0); PG8_LDB(B1, 0, 1); PG8_SCHED; PG8_LDA(At, 0, 0); PG8_STAGE(PG8_SA(1, 1), a1 + hstep, voffA);
            PG8_WAIT_V(8); PG8_WAIT_L(0); PG8_BAR; PG8_MMA(0, 0, At, B0); PG8_MMA(0, 1, At, B1); PG8_BAR; PG8_SCHED;
            PG8_LDA(At, 0, 1); PG8_STAGE(PG8_SB(0, 0), b2, voffB); PG8_STAGE(PG8_SB(0, 1), b2 + hstep, voffB); PG8_STAGE(PG8_SA(0, 0), a2, voffA);
            PG8_WAIT_V(8); PG8_WAIT_L(0); PG8_BAR; PG8_MMA(1, 0, At, B0); PG8_MMA(1, 1, At, B1); PG8_BAR; PG8_SCHED;
            PG8_LDB(B0, 1, 0); PG8_LDB(B1, 1, 1); PG8_SCHED; PG8_LDA(At, 1, 0); PG8_STAGE(PG8_SA(0, 1), a2 + hstep, voffA);
            PG8_WAIT_V(8); PG8_WAIT_L(0); PG8_BAR; PG8_MMA(0, 0, At, B0); PG8_MMA(0, 1, At, B1); PG8_BAR; PG8_SCHED;
            PG8_LDA(At, 1, 1); PG8_STAGE(PG8_SB(1, 0), b3, voffB); PG8_STAGE(PG8_SB(1, 1), b3 + hstep, voffB); PG8_STAGE(PG8_SA(1, 0), a3, voffA);
            PG8_WAIT_V(8); PG8_WAIT_L(0); PG8_BAR; PG8_MMA(1, 0, At, B0); PG8_MMA(1, 1, At, B1); PG8_BAR; PG8_SCHED;
        }
        if (wr == 0) PG8_BAR;
        E(acc, cur, wr, wc, fr, fq);
        if (!has_next) break;
#pragma unroll
        for (int a = 0; a < 2; ++a)
#pragma unroll
            for (int b = 0; b < 2; ++b)
#pragma unroll
                for (int m = 0; m < 4; ++m)
#pragma unroll
                    for (int n = 0; n < 2; ++n) acc[a][b][m][n] = (f32x4){0.f, 0.f, 0.f, 0.f};
        cur = nxt; cA = nA; cB = nB; ++ui;
        if (wr == 1) PG8_BAR;
    }
    PG8_WAIT_V(0);
    PG8_BAR;
#undef PG8_SA
#undef PG8_SB
#undef PG8_STAGE
#undef PG8_LDA
#undef PG8_LDB
#undef PG8_MMA
#undef PG8_WAIT_V
#undef PG8_WAIT_L
#undef PG8_BAR
#undef PG8_SCHED
}

typedef f32x4 Acc[2][2][4][2];

struct EpiStoreBf16 {
    bf16_t* O; int ldc;
    __device__ __forceinline__ void operator()(Acc& acc, const Unit& u, int wr, int wc, int fr, int fq) const {
        const int row0 = u.pm * BM + wr * 64 + fr, col0 = u.pn * BM + wc * 32 + 8 * fq;
#pragma unroll
        for (int ai = 0; ai < 2; ++ai)
#pragma unroll
            for (int m = 0; m < 4; ++m) { bf16_t* rowp = O + (size_t)(row0 + ai * HALF + m * 16) * ldc + col0;
#pragma unroll
                for (int bj = 0; bj < 2; ++bj) { const f32x4 v0 = acc[ai][bj][m][0], v1 = acc[ai][bj][m][1];
                    u32x4 w; w.x = cvt_pk_bf16(v0[0], v0[1]); w.y = cvt_pk_bf16(v0[2], v0[3]); w.z = cvt_pk_bf16(v1[0], v1[1]); w.w = cvt_pk_bf16(v1[2], v1[3]);
                    *(u32x4*)(rowp + bj * HALF) = w; } }
    }
};
struct EpiProj {
    bf16_t* O; const float* lbl;
    __device__ __forceinline__ void operator()(Acc& acc, const Unit& u, int wr, int wc, int fr, int fq) const {
        const int gidx = u.pn >> 1, row0 = u.pm * BM + wr * 64 + fr;
        bf16_t* base = O + (size_t)gidx * PLANE;
#pragma unroll
        for (int bj = 0; bj < 2; ++bj) {
            const int cg = (u.pn & 1) * 256 + bj * HALF + wc * 32 + 8 * fq;
            const int hd = gidx < 3 ? 64 : 128, h = gidx < 3 ? (cg >> 6) : (cg >> 7), d = cg & (hd - 1);
            float lb[8];
            if (gidx == 4 || gidx == 5) {
#pragma unroll
                for (int i = 0; i < 8; ++i) { const int k = (gidx - 4) * 512 + cg + i; lb[i] = 1.0f / (1.0f + expf(lbl[1024 + k] - lbl[k])); }
            }
#pragma unroll
            for (int ai = 0; ai < 2; ++ai)
#pragma unroll
                for (int m = 0; m < 4; ++m) {
                    const int row = row0 + ai * HALF + m * 16;
                    float v[8];
#pragma unroll
                    for (int i = 0; i < 8; ++i) v[i] = (i < 4) ? acc[ai][bj][m][0][i & 3] : acc[ai][bj][m][1][i & 3];
                    if (gidx == 3 || gidx == 7) {
#pragma unroll
                        for (int i = 0; i < 8; ++i) v[i] = fsilu(v[i]);
                    } else if (gidx == 4 || gidx == 5) {
#pragma unroll
                        for (int i = 0; i < 8; ++i) v[i] = flog(lb[i] + (1.0f - lb[i]) * fsigmoid(v[i]));
                    }
                    u32x4 w; w.x = cvt_pk_bf16(v[0], v[1]); w.y = cvt_pk_bf16(v[2], v[3]); w.z = cvt_pk_bf16(v[4], v[5]); w.w = cvt_pk_bf16(v[6], v[7]);
                    if (gidx == 2) {
                        bf16_t* vp = base + ((size_t)h * MT + (row & ~63) + d) * 64 + (row & 63);
#pragma unroll
                        for (int i = 0; i < 8; ++i) vp[i * 64] = (bf16_t)((i & 1) ? (w[i >> 1] >> 16) : (w[i >> 1] & 0xffffu));
                    } else {
                        *(u32x4*)(base + ((size_t)h * MT + row) * hd + d) = w;
                    }
                }
        }
    }
};
template <bool NRM> struct EpiResid {
    const float* xin; float* xout; const float* gate; bf16_t* HAo; const float* nw; const float* scale; float* ssq;
    __device__ __forceinline__ void operator()(Acc& acc, const Unit& u, int wr, int wc, int fr, int fq) const {
        const int row0 = u.pm * BM + wr * 64 + fr, col0 = u.pn * BM + wc * 32 + 8 * fq;
        const int bidx = (u.pm * BM) >> 13;
        const float* gp = gate + (size_t)bidx * 6144 + col0;
        f32x4 gv[2][2], gg[2][2];
#pragma unroll
        for (int bj = 0; bj < 2; ++bj)
#pragma unroll
            for (int n = 0; n < 2; ++n) { gv[bj][n] = *(const f32x4*)(gp + bj * HALF + 4 * n);
                if (NRM) gg[bj][n] = *(const f32x4*)(nw + col0 + bj * HALF + 4 * n) * (*(const f32x4*)(scale + (size_t)bidx * 6144 + col0 + bj * HALF + 4 * n) + 1.0f); }
#pragma unroll
        for (int ai = 0; ai < 2; ++ai)
#pragma unroll
            for (int m = 0; m < 4; ++m) { const int row = row0 + ai * HALF + m * 16; const size_t ro = (size_t)row * D + col0; float ss = 0.f;
#pragma unroll
                for (int bj = 0; bj < 2; ++bj) { f32x4 xo[2];
#pragma unroll
                    for (int n = 0; n < 2; ++n) { const f32x4 xi = *(const f32x4*)(xin + ro + bj * HALF + 4 * n);
                        xo[n] = xi + gv[bj][n] * acc[ai][bj][m][n];
                        *(f32x4*)(xout + ro + bj * HALF + 4 * n) = xo[n]; }
                    if (NRM) { ss += (xo[0][0] * xo[0][0] + xo[0][1] * xo[0][1]) + (xo[0][2] * xo[0][2] + xo[0][3] * xo[0][3]) + (xo[1][0] * xo[1][0] + xo[1][1] * xo[1][1]) + (xo[1][2] * xo[1][2] + xo[1][3] * xo[1][3]);
                        const f32x4 y0 = xo[0] * gg[bj][0], y1 = xo[1] * gg[bj][1];
                        u32x4 w; w.x = cvt_pk_bf16(y0[0], y0[1]); w.y = cvt_pk_bf16(y0[2], y0[3]); w.z = cvt_pk_bf16(y1[0], y1[1]); w.w = cvt_pk_bf16(y1[2], y1[3]);
                        *(u32x4*)(HAo + ro + bj * HALF) = w; } }
                if (NRM) { ss = xg_sum(ss); if (fq == 0) atomicAdd(ssq + row, ss); } }
    }
};
template <bool XF32> struct EpiResidB {
    const void* xin; const float* nwp; const float* scp; const float* gate; bf16_t* HAo; const float* nw; const float* scale; float* ssq;
    __device__ __forceinline__ void operator()(Acc& acc, const Unit& u, int wr, int wc, int fr, int fq) const {
        const int row0 = u.pm * BM + wr * 64 + fr, col0 = u.pn * BM + wc * 32 + 8 * fq;
        const int bidx = (u.pm * BM) >> 13;
        const float* gp = gate + (size_t)bidx * 6144 + col0;
        f32x4 gv[2][2], gg[2][2], rg[2][2];
#pragma unroll
        for (int bj = 0; bj < 2; ++bj)
#pragma unroll
            for (int n = 0; n < 2; ++n) { gv[bj][n] = *(const f32x4*)(gp + bj * HALF + 4 * n);
                gg[bj][n] = *(const f32x4*)(nw + col0 + bj * HALF + 4 * n) * (*(const f32x4*)(scale + (size_t)bidx * 6144 + col0 + bj * HALF + 4 * n) + 1.0f);
                if (!XF32) { const f32x4 gpv = *(const f32x4*)(nwp + col0 + bj * HALF + 4 * n) * (*(const f32x4*)(scp + (size_t)bidx * 6144 + col0 + bj * HALF + 4 * n) + 1.0f);
                    rg[bj][n] = (f32x4){frcp(gpv[0]), frcp(gpv[1]), frcp(gpv[2]), frcp(gpv[3])}; } }
#pragma unroll
        for (int ai = 0; ai < 2; ++ai)
#pragma unroll
            for (int m = 0; m < 4; ++m) { const int row = row0 + ai * HALF + m * 16; const size_t ro = (size_t)row * D + col0; float ss = 0.f;
#pragma unroll
                for (int bj = 0; bj < 2; ++bj) { f32x4 xi[2];
                    if (XF32) { xi[0] = *(const f32x4*)((const float*)xin + ro + bj * HALF); xi[1] = *(const f32x4*)((const float*)xin + ro + bj * HALF + 4); }
                    else { const u32x4 xb = *(const u32x4*)((const bf16_t*)xin + ro + bj * HALF);
                        xi[0] = (f32x4){bf2f(xb.x & 0xffffu), bf2f(xb.x >> 16), bf2f(xb.y & 0xffffu), bf2f(xb.y >> 16)};
                        xi[1] = (f32x4){bf2f(xb.z & 0xffffu), bf2f(xb.z >> 16), bf2f(xb.w & 0xffffu), bf2f(xb.w >> 16)};
                        xi[0] = xi[0] * rg[bj][0]; xi[1] = xi[1] * rg[bj][1]; }
                    const f32x4 x0 = xi[0] + gv[bj][0] * acc[ai][bj][m][0], x1 = xi[1] + gv[bj][1] * acc[ai][bj][m][1];
                    ss += (x0[0] * x0[0] + x0[1] * x0[1]) + (x0[2] * x0[2] + x0[3] * x0[3]) + (x1[0] * x1[0] + x1[1] * x1[1]) + (x1[2] * x1[2] + x1[3] * x1[3]);
                    const f32x4 y0 = x0 * gg[bj][0], y1 = x1 * gg[bj][1];
                    u32x4 w; w.x = cvt_pk_bf16(y0[0], y0[1]); w.y = cvt_pk_bf16(y0[2], y0[3]); w.z = cvt_pk_bf16(y1[0], y1[1]); w.w = cvt_pk_bf16(y1[2], y1[3]);
                    *(u32x4*)(HAo + ro + bj * HALF) = w; }
                ss = xg_sum(ss); if (fq == 0) atomicAdd(ssq + row, ss); }
    }
};
struct EpiResidOut {
    const bf16_t* xin; const float* nwp; const float* scp; float* xout; const float* gate;
    __device__ __forceinline__ void operator()(Acc& acc, const Unit& u, int wr, int wc, int fr, int fq) const {
        const int row0 = u.pm * BM + wr * 64 + fr, col0 = u.pn * BM + wc * 32 + 8 * fq;
        const float* gp = gate + (size_t)((u.pm * BM) >> 13) * 6144 + col0;
#pragma unroll
        for (int ai = 0; ai < 2; ++ai)
#pragma unroll
            for (int m = 0; m < 4; ++m) { const size_t ro = (size_t)(row0 + ai * HALF + m * 16) * D + col0;
#pragma unroll
                for (int bj = 0; bj < 2; ++bj) { const u32x4 xb = *(const u32x4*)(xin + ro + bj * HALF);
                    const f32x4 g0 = *(const f32x4*)(gp + bj * HALF), g1 = *(const f32x4*)(gp + bj * HALF + 4);
                    const size_t so = (size_t)((u.pm * BM) >> 13) * 6144 + col0 + bj * HALF;
                    const f32x4 p0 = *(const f32x4*)(nwp + col0 + bj * HALF) * (*(const f32x4*)(scp + so) + 1.0f), p1 = *(const f32x4*)(nwp + col0 + bj * HALF + 4) * (*(const f32x4*)(scp + so + 4) + 1.0f);
                    *(f32x4*)(xout + ro + bj * HALF) = (f32x4){bf2f(xb.x & 0xffffu) / p0[0], bf2f(xb.x >> 16) / p0[1], bf2f(xb.y & 0xffffu) / p0[2], bf2f(xb.y >> 16) / p0[3]} + g0 * acc[ai][bj][m][0];
                    *(f32x4*)(xout + ro + bj * HALF + 4) = (f32x4){bf2f(xb.z & 0xffffu) / p1[0], bf2f(xb.z >> 16) / p1[1], bf2f(xb.w & 0xffffu) / p1[2], bf2f(xb.w >> 16) / p1[3]} + g1 * acc[ai][bj][m][1]; } }
    }
};
struct EpiResidFinal {
    const bf16_t* xin; const float* nwp; const float* scp; float* out; const float* gate; const float* fw; float* xs; unsigned* cnt; LAS float* sl;
    __device__ __forceinline__ void operator()(Acc& acc, const Unit& u, int wr, int wc, int fr, int fq) const {
        const int row0 = u.pm * BM + wr * 64 + fr, col0 = u.pn * BM + wc * 32 + 8 * fq, tid = threadIdx.x;
        const float* gp = gate + (size_t)((u.pm * BM) >> 13) * 6144 + col0;
        {
            f32x4 gv[2][2], rg[2][2];
#pragma unroll
            for (int bj = 0; bj < 2; ++bj)
#pragma unroll
                for (int n = 0; n < 2; ++n) { gv[bj][n] = *(const f32x4*)(gp + bj * HALF + 4 * n);
                    const f32x4 gpv = *(const f32x4*)(nwp + col0 + bj * HALF + 4 * n) * (*(const f32x4*)(scp + (size_t)((u.pm * BM) >> 13) * 6144 + col0 + bj * HALF + 4 * n) + 1.0f);
                    rg[bj][n] = (f32x4){frcp(gpv[0]), frcp(gpv[1]), frcp(gpv[2]), frcp(gpv[3])}; }
#pragma unroll
            for (int ai = 0; ai < 2; ++ai)
#pragma unroll
                for (int m = 0; m < 4; ++m) { const size_t ro = (size_t)(row0 + ai * HALF + m * 16) * D + col0; float ss = 0.f;
#pragma unroll
                    for (int bj = 0; bj < 2; ++bj) { const u32x4 xb = *(const u32x4*)(xin + ro + bj * HALF);
#pragma unroll
                        for (int n = 0; n < 2; ++n) { const unsigned w0 = n ? xb.z : xb.x, w1 = n ? xb.w : xb.y;
                            const f32x4 xi = (f32x4){bf2f(w0 & 0xffffu), bf2f(w0 >> 16), bf2f(w1 & 0xffffu), bf2f(w1 >> 16)} * rg[bj][n]; const f32x4 xo = xi + gv[bj][n] * acc[ai][bj][m][n];
                            acc[ai][bj][m][n] = xo; ss += (xo[0] * xo[0] + xo[1] * xo[1]) + (xo[2] * xo[2] + xo[3] * xo[3]); } }
                    ss = xg_sum(ss);
                    if (fq == 0) sl[wc * 256 + ai * HALF + wr * 64 + m * 16 + fr] = ss; }
        }
        __syncthreads();
        if (tid < 256) { const float t = (sl[tid] + sl[256 + tid]) + (sl[512 + tid] + sl[768 + tid]);
            __hip_atomic_store(xs + ((size_t)u.pm * 4 + u.pn) * 256 + tid, t, __ATOMIC_RELAXED, __HIP_MEMORY_SCOPE_AGENT); }
        asm volatile("s_waitcnt vmcnt(0)" ::: "memory");
        __syncthreads();
        if (tid == 0) { unsigned* c = cnt + u.pm * 64;
            __hip_atomic_fetch_add(c, 1u, __ATOMIC_RELAXED, __HIP_MEMORY_SCOPE_AGENT);
            unsigned sp = 0;
            while (__hip_atomic_load(c, __ATOMIC_RELAXED, __HIP_MEMORY_SCOPE_AGENT) < 4u) { __builtin_amdgcn_s_sleep(1); if (++sp > (1u << 22)) break; } }
        __syncthreads();
        if (tid < 256) { float t = 0.f;
#pragma unroll
            for (int pn = 0; pn < 4; ++pn) t += __hip_atomic_load(xs + ((size_t)u.pm * 4 + pn) * 256 + tid, __ATOMIC_RELAXED, __HIP_MEMORY_SCOPE_AGENT);
            sl[1024 + tid] = __builtin_amdgcn_rsqf(t * (1.f / D) + EPS); }
        __syncthreads();
        f32x4 fv[2][2];
#pragma unroll
        for (int bj = 0; bj < 2; ++bj)
#pragma unroll
            for (int n = 0; n < 2; ++n) fv[bj][n] = *(const f32x4*)(fw + col0 + bj * HALF + 4 * n);
#pragma unroll
        for (int ai = 0; ai < 2; ++ai)
#pragma unroll
            for (int m = 0; m < 4; ++m) { const size_t ro = (size_t)(row0 + ai * HALF + m * 16) * D + col0; const float r = sl[1024 + ai * HALF + wr * 64 + m * 16 + fr];
#pragma unroll
                for (int bj = 0; bj < 2; ++bj)
#pragma unroll
                    for (int n = 0; n < 2; ++n) *(f32x4*)(out + ro + bj * HALF + 4 * n) = acc[ai][bj][m][n] * r * fv[bj][n]; }
    }
};
struct EpiConvGlu {
    bf16_t* T; const float* cw; const float* cb; LAS float* xch; const float* ssq; const float* sb;
    __device__ __forceinline__ void operator()(Acc& acc, const Unit& u, int wr, int wc, int fr, int fq) const {
        const int b = u.pm / 33, ti = u.pm % 33, t0 = 254 * ti - 1;
        const int lc = wc * 32 + 8 * fq, fc = u.pn * 128 + lc;
        f32x4 w0[2], w1[2], w2[2], bb[2];
#pragma unroll
        for (int n = 0; n < 2; ++n) { w0[n] = *(const f32x4*)(cw + fc + 4 * n); w1[n] = *(const f32x4*)(cw + DFF + fc + 4 * n); w2[n] = *(const f32x4*)(cw + 2 * DFF + fc + 4 * n); bb[n] = *(const f32x4*)(cb + fc + 4 * n); }
        LAS float* xf = xch; LAS float* xl = xch + 512;
        f32x4 sba[2], sbv[2];
#pragma unroll
        for (int n = 0; n < 2; ++n) { sba[n] = *(const f32x4*)(sb + (size_t)b * 2 * DFF + u.pn * 256 + lc + 4 * n); sbv[n] = *(const f32x4*)(sb + (size_t)b * 2 * DFF + u.pn * 256 + 128 + lc + 4 * n); }
#pragma unroll
        for (int ai = 0; ai < 2; ++ai) {
#pragma unroll
            for (int m = 0; m < 4; ++m) { const int tok = t0 + ai * HALF + wr * 64 + m * 16 + fr;
                if ((unsigned)tok >= (unsigned)SEQ) { acc[ai][0][m][0] = (f32x4){0.f, 0.f, 0.f, 0.f}; acc[ai][0][m][1] = (f32x4){0.f, 0.f, 0.f, 0.f}; }
                else { const float rr = __builtin_amdgcn_rsqf(ssq[b * SEQ + tok] * (1.f / D) + EPS);
                    acc[ai][0][m][0] = acc[ai][0][m][0] * rr + sba[0]; acc[ai][0][m][1] = acc[ai][0][m][1] * rr + sba[1];
                    acc[ai][1][m][0] = acc[ai][1][m][0] * rr + sbv[0]; acc[ai][1][m][1] = acc[ai][1][m][1] * rr + sbv[1]; } }
            const int rg = 2 * ai + wr;
            if (fr == 0) { *(LAS f32x4*)(xf + rg * 128 + lc) = acc[ai][0][0][0]; *(LAS f32x4*)(xf + rg * 128 + lc + 4) = acc[ai][0][0][1]; }
            if (fr == 15) { *(LAS f32x4*)(xl + rg * 128 + lc) = acc[ai][0][3][0]; *(LAS f32x4*)(xl + rg * 128 + lc + 4) = acc[ai][0][3][1]; }
        }
        __syncthreads();
#pragma unroll
        for (int ai = 0; ai < 2; ++ai) {
            const int rg = 2 * ai + wr;
            f32x4 pv[2], nv[2];
#pragma unroll
            for (int n = 0; n < 2; ++n) { pv[n] = rg > 0 ? *(const LAS f32x4*)(xl + (rg - 1) * 128 + lc + 4 * n) : (f32x4){0.f, 0.f, 0.f, 0.f};
                nv[n] = rg < 3 ? *(const LAS f32x4*)(xf + (rg + 1) * 128 + lc + 4 * n) : (f32x4){0.f, 0.f, 0.f, 0.f}; }
#pragma unroll
            for (int m = 0; m < 4; ++m) {
                const int lr = ai * HALF + wr * 64 + m * 16 + fr, tok = t0 + lr;
                f32x4 r[2];
#pragma unroll
                for (int n = 0; n < 2; ++n) {
#pragma unroll
                    for (int i = 0; i < 4; ++i) {
                        const float cur = acc[ai][0][m][n][i];
                        const float oldp = (m > 0) ? dppf<0x121>(0.f, acc[ai][0][m > 0 ? m - 1 : 0][n][i]) : pv[n][i];
                        const float prev = dppf<0x111>(oldp, cur);
                        const float oldn = (m < 3) ? dppf<0x12F>(0.f, acc[ai][0][m < 3 ? m + 1 : 3][n][i]) : nv[n][i];
                        const float next = dppf<0x101>(oldn, cur);
                        r[n][i] = w0[n][i] * prev + w1[n][i] * cur + w2[n][i] * next + bb[n][i];
                    }
                }
                const f32x2 g0 = gelu_pk((f32x2){r[0][0], r[0][1]}), g1 = gelu_pk((f32x2){r[0][2], r[0][3]}), g2 = gelu_pk((f32x2){r[1][0], r[1][1]}), g3 = gelu_pk((f32x2){r[1][2], r[1][3]});
                const f32x4 v0 = acc[ai][1][m][0], v1 = acc[ai][1][m][1];
                u32x4 w; w.x = cvt_pk_bf16(g0.x * v0[0], g0.y * v0[1]); w.y = cvt_pk_bf16(g1.x * v0[2], g1.y * v0[3]); w.z = cvt_pk_bf16(g2.x * v1[0], g2.y * v1[1]); w.w = cvt_pk_bf16(g3.x * v1[2], g3.y * v1[3]);
                if (lr >= 1 && lr <= 254 && tok < SEQ) *(u32x4*)(T + (size_t)(b * SEQ + tok) * DFF + fc) = w;
            }
        }
    }
};
struct EpiMulPair {
    bf16_t* P; const float* ssq; const float* sb;
    __device__ __forceinline__ void operator()(Acc& acc, const Unit& u, int wr, int wc, int fr, int fq) const {
        const int row0 = u.pm * BM + wr * 64 + fr, col0 = u.pn * 128 + wc * 32 + 8 * fq;
        const float* sp = sb + (size_t)((u.pm * BM) >> 13) * 3072 + u.pn * 256 + wc * 32 + 8 * fq;
        f32x4 s0[2], s1[2];
#pragma unroll
        for (int n = 0; n < 2; ++n) { s0[n] = *(const f32x4*)(sp + 4 * n); s1[n] = *(const f32x4*)(sp + 128 + 4 * n); }
#pragma unroll
        for (int ai = 0; ai < 2; ++ai)
#pragma unroll
            for (int m = 0; m < 4; ++m) { const float rr = __builtin_amdgcn_rsqf(ssq[row0 + ai * HALF + m * 16] * (1.f / D) + EPS);
                const f32x4 v0 = (acc[ai][0][m][0] * rr + s0[0]) * (acc[ai][1][m][0] * rr + s1[0]), v1 = (acc[ai][0][m][1] * rr + s0[1]) * (acc[ai][1][m][1] * rr + s1[1]);
                u32x4 w; w.x = cvt_pk_bf16(v0[0], v0[1]); w.y = cvt_pk_bf16(v0[2], v0[3]); w.z = cvt_pk_bf16(v1[0], v1[1]); w.w = cvt_pk_bf16(v1[2], v1[3]);
                *(u32x4*)(P + (size_t)(row0 + ai * HALF + m * 16) * D + col0) = w; }
    }
};
struct EpiGateConv {
    const bf16_t* P; bf16_t* Z; const float* cw; const float* cb; const float* ssq; const float* sb;
    __device__ __forceinline__ void operator()(Acc& acc, const Unit& u, int wr, int wc, int fr, int fq) const {
        const int row0 = u.pm * BM + wr * 64 + fr;
        float rr[2][4];
#pragma unroll
        for (int ai = 0; ai < 2; ++ai)
#pragma unroll
            for (int m = 0; m < 4; ++m) rr[ai][m] = __builtin_amdgcn_rsqf(ssq[row0 + ai * HALF + m * 16] * (1.f / D) + EPS);
#pragma unroll
        for (int bj = 0; bj < 2; ++bj) {
            const int col0 = u.pn * BM + bj * HALF + wc * 32 + 8 * fq;
            float w0[8], w1[8], w2[8], bb[8], sg[8];
#pragma unroll
            for (int i = 0; i < 8; ++i) { w0[i] = cw[col0 + i]; w1[i] = cw[D + col0 + i]; w2[i] = cw[2 * D + col0 + i]; bb[i] = cb[col0 + i]; sg[i] = sb[(size_t)((u.pm * BM) >> 13) * 3072 + 2048 + col0 + i]; }
#pragma unroll
            for (int ai = 0; ai < 2; ++ai)
#pragma unroll
                for (int m = 0; m < 4; ++m) {
                    const int row = row0 + ai * HALF + m * 16, tok = row & (SEQ - 1);
                    const bf16_t* pp = P + (size_t)row * D + col0;
                    const u32x4 z4 = (u32x4){0u, 0u, 0u, 0u};
                    const u32x4 pc = *(const u32x4*)pp;
                    u32x4 pe = z4;
                    if (fr == 0 && tok > 0) pe = *(const u32x4*)(pp - D);
                    if (fr == 15 && tok < SEQ - 1) pe = *(const u32x4*)(pp + D);
                    u32x4 pm, pn;
#pragma unroll
                    for (int q = 0; q < 4; ++q) { pm[q] = (unsigned)__builtin_amdgcn_update_dpp((int)pe[q], (int)pc[q], 0x111, 0xF, 0xF, false);
                        pn[q] = (unsigned)__builtin_amdgcn_update_dpp((int)pe[q], (int)pc[q], 0x101, 0xF, 0xF, false); }
                    float o[8];
#pragma unroll
                    for (int i = 0; i < 8; ++i) {
                        const unsigned sh = (i & 1) ? 16u : 0u;
                        const float c = bf2f((pc[i >> 1] >> sh) & 0xffffu), pr = bf2f((pm[i >> 1] >> sh) & 0xffffu), nx = bf2f((pn[i >> 1] >> sh) & 0xffffu);
                        const float a = ((i < 4) ? acc[ai][bj][m][0][i & 3] : acc[ai][bj][m][1][i & 3]) * rr[ai][m] + sg[i];
                        o[i] = a * (w0[i] * pr + w1[i] * c + w2[i] * nx + bb[i]);
                    }
                    u32x4 w; w.x = cvt_pk_bf16(o[0], o[1]); w.y = cvt_pk_bf16(o[2], o[3]); w.z = cvt_pk_bf16(o[4], o[5]); w.w = cvt_pk_bf16(o[6], o[7]);
                    *(u32x4*)(Z + (size_t)row * D + col0) = w;
                }
        }
    }
};
}

template <int MAP> __device__ __forceinline__ int map_row(int n0) {
    if (MAP == 0) return n0;
    if (MAP == 1) { if (n0 < DFF) return (n0 >> 7) * 256 + (n0 & 127); const int n = n0 - DFF; return (n >> 7) * 256 + 128 + (n & 127); }
    if (n0 < 1024) return 2048 + n0;
    if (n0 < 2048) { const int n = n0 - 1024; return (n >> 7) * 256 + (n & 127); }
    const int n = n0 - 2048; return (n >> 7) * 256 + 128 + (n & 127);
}
template <int MAP, bool BIAS> __device__ __forceinline__ void transpose_item(const float* W, int K, int N, bf16_t* WT, LAS float* scr, int item, int lane,
                                                                           const LAS float* shift = nullptr, float* sb = nullptr, int sbs = 0) {
    const int nblk = N / 32, kb = item / nblk, nb = item % nblk, k0 = 64 * kb, n0 = 32 * nb;
    float p0 = 0.f, p1 = 0.f;
#pragma unroll 8
    for (int i = 0; i < 32; ++i) { const int kk = 2 * i + (lane >> 5); const float w = __builtin_nontemporal_load(W + (size_t)(k0 + kk) * N + n0 + (lane & 31)); scr[kk * 33 + (lane & 31)] = w;
        if (BIAS) { p0 += w * shift[k0 + kk]; p1 += w * shift[1024 + k0 + kk]; } }
    LDS_WAIT();
    const int c = lane & 7, r0 = map_row<MAP>(n0);
    if (BIAS) {
        const unsigned u0 = __builtin_bit_cast(unsigned, p0), u1 = __builtin_bit_cast(unsigned, p1);
        const auto q0 = __builtin_amdgcn_permlane32_swap(u0, u0, false, false); const auto q1 = __builtin_amdgcn_permlane32_swap(u1, u1, false, false);
        const float t0 = __builtin_bit_cast(float, (unsigned)q0[0]) + __builtin_bit_cast(float, (unsigned)q0[1]), t1 = __builtin_bit_cast(float, (unsigned)q1[0]) + __builtin_bit_cast(float, (unsigned)q1[1]);
        if (lane < 32) { atomicAdd(sb + r0 + lane, t0); atomicAdd(sb + sbs + r0 + lane, t1); }
    }
#pragma unroll
    for (int j = 0; j < 4; ++j) { const int n = (lane >> 3) + 8 * j; const LAS float* s = scr + (8 * c) * 33 + n;
        u32x4 o; o.x = cvt_pk_bf16(s[0 * 33], s[1 * 33]); o.y = cvt_pk_bf16(s[2 * 33], s[3 * 33]); o.z = cvt_pk_bf16(s[4 * 33], s[5 * 33]); o.w = cvt_pk_bf16(s[6 * 33], s[7 * 33]);
        *(u32x4*)(WT + (size_t)(r0 + n) * K + k0 + 8 * c) = o; }
    LDS_WAIT();
}
__device__ __forceinline__ void norm_mod_row(const float* xrow, const float* w, const float* shift, const float* scale, bf16_t* orow, int lane) {
    f32x4 v[4]; float s = 0.f;
#pragma unroll
    for (int j = 0; j < 4; ++j) { v[j] = __builtin_nontemporal_load((const f32x4*)(xrow + 4 * lane + 256 * j)); s += (v[j].x * v[j].x + v[j].y * v[j].y) + (v[j].z * v[j].z + v[j].w * v[j].w); }
    const float r = __builtin_amdgcn_rsqf(wave_sum(s) * (1.f / D) + EPS);
#pragma unroll
    for (int j = 0; j < 4; ++j) { const int c = 4 * lane + 256 * j;
        const f32x4 ww = *(const f32x4*)(w + c), sh = *(const f32x4*)(shift + c), sc = *(const f32x4*)(scale + c);
        const f32x4 y = v[j] * r * ww * (sc + 1.0f) + sh;
        u32x2 o; o.x = cvt_pk_bf16(y.x, y.y); o.y = cvt_pk_bf16(y.z, y.w);
        *(u32x2*)(orow + c) = o; }
}

#define XB_TMO      128
#define XB_XCNT(j)  (256  + 64 * (j))
#define XB_XSUB(j)  (1280 + 64 * (j))
#define XB_XGEN(j)  (2304 + 64 * (j))
#define XB_TOP      3328
#define XB_TOPGEN   3392
#define XCD_BAR_WORDS 3456
#define XB_SPIN_CAP (1u << 18)
__device__ __forceinline__ unsigned xb_ld(unsigned* p)              { return __hip_atomic_load(p, __ATOMIC_RELAXED, __HIP_MEMORY_SCOPE_AGENT); }
__device__ __forceinline__ unsigned xb_add(unsigned* p, unsigned v) { return __hip_atomic_fetch_add(p, v, __ATOMIC_RELAXED, __HIP_MEMORY_SCOPE_AGENT); }
__device__ __forceinline__ unsigned xb_xcc_id() { return (unsigned)__builtin_amdgcn_s_getreg((3 << 11) | 20) & 0xFu; }
#define XB_SPIN(cond, bar) do { unsigned _sp = 0; while (cond) { __builtin_amdgcn_s_sleep(1); \
    if ((++_sp & 255u) == 0u) { if (xb_ld(&(bar)[XB_TMO])) break; if (_sp > XB_SPIN_CAP) { atomicAdd(&(bar)[XB_TMO], 1u); break; } } } } while (0)
struct XcdBarrier { unsigned* bar; unsigned x; volatile LAS unsigned* st; };
__device__ __forceinline__ XcdBarrier xcd_barrier_post(unsigned* bar, volatile LAS unsigned* st) {
    XcdBarrier b; b.bar = bar; b.x = xb_xcc_id(); b.st = st;
    if (threadIdx.x == 0) (void)xb_add(&bar[XB_XCNT(b.x)], 1u);
    return b;
}
__device__ __forceinline__ void xcd_barrier_complete(unsigned* bar, unsigned x, unsigned& nloc, unsigned& nx) {
    const unsigned G = gridDim.x * gridDim.y * gridDim.z;
    unsigned sum, cnt, mine, sp = 0u;
    for (;;) {
        sum = 0u; cnt = 0u; mine = 0u;
#pragma unroll
        for (unsigned j = 0; j < 16; ++j) { const unsigned c = xb_ld(&bar[XB_XCNT(j)]); sum += c; cnt += (c > 0u) ? 1u : 0u; mine = (j == x) ? c : mine; }
        if (sum == G) break;
        __builtin_amdgcn_s_sleep(1);
        if ((++sp & 255u) == 0u) { if (xb_ld(&bar[XB_TMO])) break; if (sp > XB_SPIN_CAP) { atomicAdd(&bar[XB_TMO], 1u); break; } }
    }
    nloc = mine > 0u ? mine : 1u; nx = cnt > 0u ? cnt : 1u;
}
__device__ __forceinline__ void xcd_barrier(const XcdBarrier& b) {
    asm volatile("s_waitcnt vmcnt(0)" ::: "memory");
    __syncthreads();
    if (threadIdx.x == 0) {
        unsigned* bar = b.bar;
        __builtin_amdgcn_s_waitcnt(0);
        unsigned nloc = b.st[0], nx = b.st[1];
        if (nloc == 0u) { xcd_barrier_complete(bar, b.x, nloc, nx); b.st[0] = nloc; b.st[1] = nx; }
        const unsigned old = xb_add(&bar[XB_XSUB(b.x)], 1u);
        const unsigned gen = old / nloc;
        if (old + 1u == (gen + 1u) * nloc) {
            __builtin_amdgcn_fence(__ATOMIC_RELEASE, "agent");
            asm volatile("s_waitcnt vmcnt(0)" ::: "memory");
            const unsigned og = xb_add(&bar[XB_TOP], 1u);
            const unsigned tg = og / nx;
            if (og + 1u == (tg + 1u) * nx) xb_add(&bar[XB_TOPGEN], 1u);
            else XB_SPIN(xb_ld(&bar[XB_TOPGEN]) == tg, bar);
            __builtin_amdgcn_fence(__ATOMIC_ACQUIRE, "agent");
            xb_add(&bar[XB_XGEN(b.x)], 1u);
            asm volatile("s_waitcnt vmcnt(0)" ::: "memory");
        } else {
            XB_SPIN(xb_ld(&bar[XB_XGEN(b.x)]) == gen, bar);
            __builtin_amdgcn_fence(__ATOMIC_ACQUIRE, "agent");
            asm volatile("s_waitcnt vmcnt(0)" ::: "memory");
        }
    }
    __syncthreads();
}
__device__ __forceinline__ void norm_mod_row2(const float* x0, const float* x1, const float* w, const float* shift, const float* scale, bf16_t* o0, bf16_t* o1, int lane) {
    f32x4 v0[4], v1[4]; float s0 = 0.f, s1 = 0.f;
#pragma unroll
    for (int j = 0; j < 4; ++j) { v0[j] = *(const f32x4*)(x0 + 4 * lane + 256 * j); v1[j] = *(const f32x4*)(x1 + 4 * lane + 256 * j); }
#pragma unroll
    for (int j = 0; j < 4; ++j) { s0 += (v0[j].x * v0[j].x + v0[j].y * v0[j].y) + (v0[j].z * v0[j].z + v0[j].w * v0[j].w); s1 += (v1[j].x * v1[j].x + v1[j].y * v1[j].y) + (v1[j].z * v1[j].z + v1[j].w * v1[j].w); }
    const float r0 = __builtin_amdgcn_rsqf(wave_sum(s0) * (1.f / D) + EPS), r1 = __builtin_amdgcn_rsqf(wave_sum(s1) * (1.f / D) + EPS);
#pragma unroll
    for (int j = 0; j < 4; ++j) { const int c = 4 * lane + 256 * j;
        const f32x4 ww = *(const f32x4*)(w + c), sh = *(const f32x4*)(shift + c), sc = *(const f32x4*)(scale + c);
        const f32x4 g = ww * (sc + 1.0f), y0 = v0[j] * r0 * g + sh, y1 = v1[j] * r1 * g + sh;
        u32x2 a; a.x = cvt_pk_bf16(y0.x, y0.y); a.y = cvt_pk_bf16(y0.z, y0.w); *(u32x2*)(o0 + c) = a;
        u32x2 b; b.x = cvt_pk_bf16(y1.x, y1.y); b.y = cvt_pk_bf16(y1.z, y1.w); *(u32x2*)(o1 + c) = b; }
}

struct Args {
    const float *x, *c, *ctx, *c_ctx, *ada_w, *ada_b, *norm_mix_w, *norm_ffn_w, *ev_w_in, *ev_w_out, *na_rpb, *hg_lb, *hg_norm_w,
        *od_w_in, *od_conv_w, *od_conv_b, *od_w_out, *ffn_w_up, *ffn_conv_w, *ffn_conv_b, *ffn_w_down, *final_norm_w;
    float* out; unsigned char* ws;
    int ph_lo, ph_hi;
};

#define NA_SKIPK(qt, sb, kt) (LAT && (((qt) == 1 && (sb) == 1 && (kt) == 1) || ((qt) == 2 && (sb) == 0 && (kt) == 0)))
template <bool LAT>
__device__ __forceinline__ void na_kblock(const LAS unsigned char* Ks, const LAS unsigned char* Vt, const LAS float* Bs, const bf16x8 (&Qf)[4][2], f32x4 (&O)[4][4], float (&mrun)[4], float (&lrun)[4],
                                          int rrel31, int fr, int g) {
    const float SC = 0.125f * LOG2E;
#pragma unroll
    for (int sb = 0; sb < 2; ++sb) {
        int g4 = g * 4 + sb * 32; asm volatile("" : "+v"(g4));
        bf16x8 Ak[2][2];
#pragma unroll
        for (int kt = 0; kt < 2; ++kt)
#pragma unroll
            for (int kk = 0; kk < 2; ++kk) { const int key = sb * 32 + kt * 16 + fr, ch = kk * 4 + g;
                Ak[kt][kk] = *(const LAS bf16x8*)(Ks + key * 128 + ((ch ^ (key & 7)) * 16)); }
#pragma unroll
        for (int qt = 0; qt < 4; ++qt) {
            if (LAT && ((qt == 3 && sb == 0) || (qt == 0 && sb == 1))) continue;
            f32x4 S[2];
#pragma unroll
            for (int kt = 0; kt < 2; ++kt) { S[kt] = (f32x4){0.f, 0.f, 0.f, 0.f};
                if (NA_SKIPK(qt, sb, kt)) continue;
#pragma unroll
                for (int kk = 0; kk < 2; ++kk) S[kt] = __builtin_amdgcn_mfma_f32_16x16x32_bf16(Ak[kt][kk], Qf[qt][kk], S[kt], 0, 0, 0); }
            const int q = qt * 16 + fr, cs = min(max(q - 8, 0), 48);
            float z[2][4]; float mx = -1e30f;
#pragma unroll
            for (int kt = 0; kt < 2; ++kt)
#pragma unroll
                for (int j = 0; j < 4; ++j) {
                    if (NA_SKIPK(qt, sb, kt)) { z[kt][j] = 0.f; continue; }
                    float zz = S[kt][j] * SC;
                    if (LAT) { const int kc = g4 + kt * 16 + j; const bool valid = (unsigned)(kc - cs) < 16u;
                        const int bi = valid ? rrel31 + kc - q + 15 : 465;
                        zz += Bs[bi]; }
                    z[kt][j] = zz; mx = fmaxf(mx, zz);
                }
            __builtin_amdgcn_sched_barrier(0);
            mx = xg_max(mx);
            const float mnew = fmaxf(mrun[qt], mx), alpha = fexp2(mrun[qt] - mnew);
            mrun[qt] = mnew;
            float ps = 0.f;
#pragma unroll
            for (int kt = 0; kt < 2; ++kt)
#pragma unroll
                for (int j = 0; j < 4; ++j) { if (NA_SKIPK(qt, sb, kt)) continue; z[kt][j] = fexp2(z[kt][j] - mnew); ps += z[kt][j]; }
            lrun[qt] = lrun[qt] * alpha + ps;
            u32x4 pk; pk.x = cvt_pk_bf16(z[0][0], z[0][1]); pk.y = cvt_pk_bf16(z[0][2], z[0][3]); pk.z = cvt_pk_bf16(z[1][0], z[1][1]); pk.w = cvt_pk_bf16(z[1][2], z[1][3]);
            const bf16x8 Pb = __builtin_bit_cast(bf16x8, pk);
#pragma unroll
            for (int dt = 0; dt < 4; ++dt) {
                const LAS unsigned char* vp = Vt + (dt * 16 + fr) * 144 + (sb * 32 + g * 4) * 2;
                const u32x2 lo = *(const LAS u32x2*)vp, hi = *(const LAS u32x2*)(vp + 32);
                const bf16x8 A = __builtin_bit_cast(bf16x8, (u32x4){lo.x, lo.y, hi.x, hi.y});
                O[dt][qt] = __builtin_amdgcn_mfma_f32_16x16x32_bf16(A, Pb, O[dt][qt] * alpha, 0, 0, 0);
            }
        }
    }
}
__device__ __forceinline__ void na_stage(LAS unsigned char* Ks, LAS unsigned char* Vt, const bf16_t* __restrict__ proj, size_t krow0, int h, int lane) {
    LDS_WAIT();
#pragma unroll 4
    for (int it = 0; it < 8; ++it) { const int key = it * 8 + (lane >> 3), ch = lane & 7;
        const u32x4 v = *(const u32x4*)(proj + PLANE + ((size_t)h * MT + krow0 + key) * 64 + ch * 8);
        *(LAS u32x4*)(Ks + key * 128 + ((ch ^ (key & 7)) * 16)) = v; }
    asm volatile("" ::: "memory");
#pragma unroll 4
    for (int it = 0; it < 8; ++it) { const int d = it * 8 + (lane >> 3), ch = lane & 7;
        const u32x4 v = *(const u32x4*)(proj + 2 * PLANE + ((size_t)h * MT + krow0 + d) * 64 + ch * 8);
        *(LAS u32x4*)(Vt + d * 144 + ch * 16) = v; }
    LDS_WAIT();
}
__device__ __forceinline__ void na_item(LAS unsigned char* lds, const bf16_t* __restrict__ proj, const float* __restrict__ rpb, bf16_t* __restrict__ mix, int item, int wid, int lane) {
    const int b = item >> 7, r = item & 127, h = wid, fr = lane & 15, g = lane >> 4;
    LAS unsigned char* Ks = lds + wid * NA_WAVE_BYTES;
    LAS unsigned char* Vt = Ks + 8192;
    LAS float* Bs = (LAS float*)(Vt + 9216);
    for (int i = lane; i < 466; i += 64) Bs[i] = i < 465 ? rpb[h * 465 + i] * LOG2E : -1e30f;
    const int r0 = min(max(r - 4, 0), 120);
    const size_t qrow0 = (size_t)(b * SEQ + r * 64);
    bf16x8 Qf[4][2];
#pragma unroll
    for (int qt = 0; qt < 4; ++qt)
#pragma unroll
        for (int kk = 0; kk < 2; ++kk) Qf[qt][kk] = *(const bf16x8*)(proj + ((size_t)h * MT + qrow0 + qt * 16 + fr) * 64 + kk * 32 + g * 8);
    f32x4 O[4][4];
    float mrun[4], lrun[4];
#pragma unroll
    for (int a = 0; a < 4; ++a) { mrun[a] = -1e4f; lrun[a] = 0.f;
#pragma unroll
        for (int c = 0; c < 4; ++c) O[a][c] = (f32x4){0.f, 0.f, 0.f, 0.f}; }
#pragma unroll 1
    for (int kb = 0; kb < 8; ++kb) {
        na_stage(Ks, Vt, proj, (size_t)(b * SEQ + (r0 + kb) * 64), h, lane);
        na_kblock<true>(Ks, Vt, Bs, Qf, O, mrun, lrun, ((r0 + kb) - r + 7) * 31, fr, g);
    }
#pragma unroll 1
    for (int kb = 0; kb < 4; ++kb) {
        na_stage(Ks, Vt, proj, (size_t)(M + b * CTXL + kb * 64), h, lane);
        na_kblock<false>(Ks, Vt, Bs, Qf, O, mrun, lrun, 0, fr, g);
    }
#pragma unroll
    for (int qt = 0; qt < 4; ++qt) {
        float l = xg_sum(lrun[qt]);
        const float inv = 1.0f / l;
        bf16_t* op = mix + (qrow0 + qt * 16 + fr) * D + h * 64 + g * 4;
#pragma unroll
        for (int dt = 0; dt < 4; ++dt) { const f32x4 o = O[dt][qt] * inv; u32x2 w; w.x = cvt_pk_bf16(o[0], o[1]); w.y = cvt_pk_bf16(o[2], o[3]); *(u32x2*)(op + dt * 16) = w; }
    }
    LDS_WAIT();
}

struct HgGeom { int b, h, dir; size_t row0; };

__device__ __forceinline__ float hg_lb(const float* lbl, int dir, int k) {
    const float l0 = lbl[dir * 512 + k], l1 = lbl[1024 + dir * 512 + k];
    return 1.0f / (1.0f + expf(l1 - l0));
}

#define BAR_LDS() do { asm volatile("s_waitcnt lgkmcnt(0)" ::: "memory"); __builtin_amdgcn_s_barrier(); asm volatile("" ::: "memory"); } while (0)
struct Raw16 { unsigned short v[16]; };
__device__ __forceinline__ Raw16 hg_load16(const bf16_t* __restrict__ proj, int grp, int h, size_t row0, int seg, int kd, bool rev) {
    Raw16 r; const bf16_t* P = proj + (size_t)grp * PLANE + ((size_t)h * MT + row0) * 128 + kd;
#pragma unroll
    for (int i = 0; i < 16; ++i) { const int tn = rev ? 16 * seg + 15 - i : 16 * seg + i; r.v[i] = P[tn * 128]; }
    return r;
}
__device__ __forceinline__ void hg_write_vt(LAS unsigned char* VT, const Raw16& vv, int kd, int seg) {
    u32x4 a, bq;
    a.x = vv.v[0] | ((unsigned)vv.v[1] << 16); a.y = vv.v[2] | ((unsigned)vv.v[3] << 16); a.z = vv.v[4] | ((unsigned)vv.v[5] << 16); a.w = vv.v[6] | ((unsigned)vv.v[7] << 16);
    bq.x = vv.v[8] | ((unsigned)vv.v[9] << 16); bq.y = vv.v[10] | ((unsigned)vv.v[11] << 16); bq.z = vv.v[12] | ((unsigned)vv.v[13] << 16); bq.w = vv.v[14] | ((unsigned)vv.v[15] << 16);
    *(LAS u32x4*)(VT + kd * 144 + seg * 32) = a; *(LAS u32x4*)(VT + kd * 144 + seg * 32 + 16) = bq;
}
struct PAItem { int chain, ci, dir, h; size_t row0; };
__device__ __forceinline__ PAItem pa_item(int it) {
    PAItem I; I.chain = it / NCHT; I.ci = it % NCHT; I.dir = I.chain & 1; I.h = (I.chain >> 1) & 3; const int b = I.chain >> 3;
    if (I.ci < 4) { const int a0 = I.dir ? CTXL - 64 * (I.ci + 1) : 64 * I.ci; I.row0 = (size_t)(M + b * CTXL + a0); }
    else { const int j = I.ci - 4; const int a0 = I.dir ? SEQ - 64 * (j + 1) : 64 * j; I.row0 = (size_t)(b * SEQ + a0); }
    return I;
}
__device__ __forceinline__ void hg_passA_phase(LAS unsigned char* lds, const bf16_t* __restrict__ proj, const float* __restrict__ lbl, bf16_t* __restrict__ STATE, bf16_t* __restrict__ HKVC,
                                               float* __restrict__ HDEC, int bid, int G, int tid) {
    LAS unsigned char* KDT = lds;
    LAS unsigned char* VT = lds + 18432;
    LAS float* SEG = (LAS float*)(lds + 36864);
    const int seg = tid >> 7, kd = tid & 127, wid = tid >> 6, lane = tid & 63, fr = lane & 15, g = lane >> 4;
    const int NIT = NCHAIN * NCHT;
    int it = bid;
    if (it >= NIT) return;
    PAItem I = pa_item(it);
    Raw16 fr_ = hg_load16(proj, 4 + I.dir, I.h, I.row0, seg, kd, I.dir != 0);
    Raw16 vr_ = hg_load16(proj, 6, I.h, I.row0, seg, kd, false);
    for (; it < NIT; it += G) {
        const PAItem C = I;
        float c[16], kk[16];
#pragma unroll
        for (int i = 0; i < 16; ++i) { c[i] = bf2f(fr_.v[i]); kk[i] = 1.0f - fexp(c[i]); }
#pragma unroll
        for (int i = 1; i < 16; ++i) c[i] += c[i - 1];
        SEG[seg * 128 + kd] = c[15];
        hg_write_vt(VT, vr_, kd, seg);
        asm volatile("" ::: "memory");
        if (it + G < NIT) { I = pa_item(it + G);
            fr_ = hg_load16(proj, 4 + I.dir, I.h, I.row0, seg, kd, I.dir != 0);
            vr_ = hg_load16(proj, 6, I.h, I.row0, seg, kd, false); }
        BAR_LDS();
        const float s0 = SEG[kd], s1 = SEG[128 + kd], s2 = SEG[256 + kd], s3 = SEG[384 + kd];
        const float btot = (s0 + s1) + (s2 + s3);
        float off;
        if (C.dir == 0) off = (seg > 0 ? s0 : 0.f) + (seg > 1 ? s1 : 0.f) + (seg > 2 ? s2 : 0.f);
        else off = (seg < 3 ? s3 : 0.f) + (seg < 2 ? s2 : 0.f) + (seg < 1 ? s1 : 0.f);
#pragma unroll
        for (int i = 0; i < 16; ++i) { const int tn = C.dir ? 16 * seg + 15 - i : 16 * seg + i;
            const float kdv = kk[i] * fexp(btot - (off + c[i]));
            *(LAS unsigned short*)(KDT + kd * 144 + tn * 2) = (unsigned short)(cvt_pk_bf16(kdv, 0.f) & 0xffffu); }
        if (seg == 0) HDEC[((size_t)C.chain * NCHT + C.ci) * 128 + kd] = fexp(btot);
        BAR_LDS();
        bf16_t* STout = C.ci < 4 ? HKVC + ((size_t)C.chain * 4 + C.ci) * 16384 : STATE + ((size_t)C.chain * NCH + (C.ci - 4)) * 16384;
        bf16x8 A[2];
#pragma unroll
        for (int kb = 0; kb < 2; ++kb) A[kb] = *(const LAS bf16x8*)(KDT + (wid * 16 + fr) * 144 + (kb * 32 + g * 8) * 2);
#pragma unroll
        for (int vt = 0; vt < 8; ++vt) {
            f32x4 acc = (f32x4){0.f, 0.f, 0.f, 0.f};
#pragma unroll
            for (int kb = 0; kb < 2; ++kb) { const bf16x8 Bv = *(const LAS bf16x8*)(VT + (vt * 16 + fr) * 144 + (kb * 32 + g * 8) * 2);
                acc = __builtin_amdgcn_mfma_f32_16x16x32_bf16(A[kb], Bv, acc, 0, 0, 0); }
            u32x2 w; w.x = cvt_pk_bf16(acc[0], acc[1]); w.y = cvt_pk_bf16(acc[2], acc[3]);
            *(u32x2*)(STout + (size_t)(vt * 16 + fr) * 128 + wid * 16 + g * 4) = w;
        }
        BAR_LDS();
    }
}

__device__ __forceinline__ void hg_passC_phase(LAS unsigned char* lds, const bf16_t* __restrict__ proj, const float* __restrict__ lbl, const float* __restrict__ hnw,
                                               const bf16_t* __restrict__ STATE, bf16_t* __restrict__ mix, int bid, int G, int tid) {
    LAS unsigned char* QE = lds;
    LAS unsigned char* KE = lds + 17408;
    LAS unsigned char* QI = lds + 34816;
    LAS unsigned char* VT = lds + 52224;
    LAS float* SEG = (LAS float*)(lds + 70656);
    LAS float* RED = (LAS float*)(lds + 72704);
    const int seg = tid >> 7, kd = tid & 127, wid = tid >> 6, lane = tid & 63, fr = lane & 15, g = lane >> 4;
    const int tt = wid & 3, vh = wid >> 2;
    const int NITEM = 8 * NCH;
    if (bid >= NITEM) return;
    const int nsteps = 2 * ((NITEM - bid + G - 1) / G);
    Raw16 fq_f, fq_q, vraw;
    { const int it0 = bid, bh = it0 / NCH, jn = it0 % NCH, b = bh >> 2, h = bh & 3; const size_t row0 = (size_t)(b * SEQ + jn * 64);
      fq_f = hg_load16(proj, 4, h, row0, seg, kd, false); fq_q = hg_load16(proj, 3, h, row0, seg, kd, false);
      vraw = hg_load16(proj, 6, h, row0, seg, kd, false); }
    f32x4 O[4];
    for (int s = 0; s < nsteps; ++s) {
        const int item = bid + (s >> 1) * G, dir = s & 1, bh = item / NCH, jn = item % NCH, b = bh >> 2, h = bh & 3;
        const size_t row0 = (size_t)(b * SEQ + jn * 64);
        if (dir == 0) {
            hg_write_vt(VT, vraw, kd, seg);
#pragma unroll
            for (int vt = 0; vt < 4; ++vt) O[vt] = (f32x4){0.f, 0.f, 0.f, 0.f};
        }
        float c[16], kk[16], qs[16];
#pragma unroll
        for (int i = 0; i < 16; ++i) { c[i] = bf2f(fq_f.v[i]); kk[i] = 1.0f - fexp(c[i]); qs[i] = bf2f(fq_q.v[i]); }
#pragma unroll
        for (int i = 1; i < 16; ++i) c[i] += c[i - 1];
        SEG[seg * 128 + kd] = c[15];
        asm volatile("" ::: "memory");
        const int chain = (b * 4 + h) * 2 + dir, js = dir ? (NCH - 1 - jn) : jn;
        const bf16_t* ST = STATE + ((size_t)chain * NCH + js) * 16384;
        bf16x8 As[4][4];
#pragma unroll
        for (int vt = 0; vt < 4; ++vt)
#pragma unroll
            for (int kb = 0; kb < 4; ++kb) As[vt][kb] = *(const bf16x8*)(ST + (size_t)((vh * 4 + vt) * 16 + fr) * 128 + kb * 32 + g * 8);
        if (s + 1 < nsteps) {
            const int ni = bid + ((s + 1) >> 1) * G, nd = (s + 1) & 1, nbh = ni / NCH, njn = ni % NCH, nb = nbh >> 2, nh = nbh & 3; const size_t nrow0 = (size_t)(nb * SEQ + njn * 64);
            fq_f = hg_load16(proj, 4 + nd, nh, nrow0, seg, kd, nd != 0); fq_q = hg_load16(proj, 3, nh, nrow0, seg, kd, nd != 0);
            if (nd == 0) vraw = hg_load16(proj, 6, nh, nrow0, seg, kd, false);
        }
        BAR_LDS();
        const float s0 = SEG[kd], s1 = SEG[128 + kd], s2 = SEG[256 + kd], s3 = SEG[384 + kd];
        float off, bmid;
        if (dir == 0) { off = (seg > 0 ? s0 : 0.f) + (seg > 1 ? s1 : 0.f) + (seg > 2 ? s2 : 0.f); bmid = s0 + s1; }
        else { off = (seg < 3 ? s3 : 0.f) + (seg < 2 ? s2 : 0.f) + (seg < 1 ? s1 : 0.f); bmid = s3 + s2; }
#pragma unroll
        for (int i = 0; i < 16; ++i) { const int tn = dir ? 16 * seg + 15 - i : 16 * seg + i;
            const float bc = off + c[i];
            const float qe = qs[i] * fexp(bc - bmid), ke = kk[i] * fexp(bmid - bc), qi = qs[i] * fexp(bc);
            const unsigned pk = cvt_pk_bf16(qe, ke);
            *(LAS unsigned short*)(QE + tn * 272 + kd * 2) = (unsigned short)(pk & 0xffffu);
            *(LAS unsigned short*)(KE + tn * 272 + kd * 2) = (unsigned short)(pk >> 16);
            *(LAS unsigned short*)(QI + tn * 272 + kd * 2) = (unsigned short)(cvt_pk_bf16(qi, 0.f) & 0xffffu); }
        BAR_LDS();
        bf16x8 Bq[4];
#pragma unroll
        for (int kb = 0; kb < 4; ++kb) Bq[kb] = *(const LAS bf16x8*)(QE + (tt * 16 + fr) * 272 + (kb * 32 + g * 8) * 2);
        f32x4 att[4];
#pragma unroll
        for (int st = 0; st < 4; ++st) {
            f32x4 a = (f32x4){0.f, 0.f, 0.f, 0.f};
#pragma unroll
            for (int kb = 0; kb < 4; ++kb) { const bf16x8 Ak = *(const LAS bf16x8*)(KE + (st * 16 + fr) * 272 + (kb * 32 + g * 8) * 2);
                a = __builtin_amdgcn_mfma_f32_16x16x32_bf16(Ak, Bq[kb], a, 0, 0, 0); }
            const int t = tt * 16 + fr;
#pragma unroll
            for (int j = 0; j < 4; ++j) { const int sx = st * 16 + g * 4 + j; const bool keep = dir ? (sx >= t) : (sx <= t); a[j] = keep ? a[j] : 0.f; }
            att[st] = a;
        }
        bf16x8 Pb[2];
#pragma unroll
        for (int cp = 0; cp < 2; ++cp) { u32x4 pk; pk.x = cvt_pk_bf16(att[2 * cp][0], att[2 * cp][1]); pk.y = cvt_pk_bf16(att[2 * cp][2], att[2 * cp][3]);
            pk.z = cvt_pk_bf16(att[2 * cp + 1][0], att[2 * cp + 1][1]); pk.w = cvt_pk_bf16(att[2 * cp + 1][2], att[2 * cp + 1][3]); Pb[cp] = __builtin_bit_cast(bf16x8, pk); }
#pragma unroll
        for (int kb = 0; kb < 4; ++kb) Bq[kb] = *(const LAS bf16x8*)(QI + (tt * 16 + fr) * 272 + (kb * 32 + g * 8) * 2);
#pragma unroll
        for (int vt = 0; vt < 4; ++vt) {
            const int vd = (vh * 4 + vt) * 16 + fr;
#pragma unroll
            for (int cp = 0; cp < 2; ++cp) {
                const LAS unsigned char* vp = VT + vd * 144 + (cp * 32 + g * 4) * 2;
                const u32x2 lo = *(const LAS u32x2*)vp, hi = *(const LAS u32x2*)(vp + 32);
                const bf16x8 Av = __builtin_bit_cast(bf16x8, (u32x4){lo.x, lo.y, hi.x, hi.y});
                O[vt] = __builtin_amdgcn_mfma_f32_16x16x32_bf16(Av, Pb[cp], O[vt], 0, 0, 0);
            }
#pragma unroll
            for (int kb = 0; kb < 4; ++kb) O[vt] = __builtin_amdgcn_mfma_f32_16x16x32_bf16(As[vt][kb], Bq[kb], O[vt], 0, 0, 0);
        }
        if (dir == 1) {
            const size_t orow = row0 + tt * 16 + fr;
            u32x2 gp[4];
#pragma unroll
            for (int vt = 0; vt < 4; ++vt) gp[vt] = *(const u32x2*)(proj + 7 * PLANE + ((size_t)h * MT + orow) * 128 + (vh * 4 + vt) * 16 + g * 4);
            float ss = 0.f;
#pragma unroll
            for (int vt = 0; vt < 4; ++vt) ss += (O[vt][0] * O[vt][0] + O[vt][1] * O[vt][1]) + (O[vt][2] * O[vt][2] + O[vt][3] * O[vt][3]);
            ss = xg_sum(ss);
            if (g == 0) RED[vh * 64 + tt * 16 + fr] = ss;
            BAR_LDS();
            const float tot = RED[tt * 16 + fr] + RED[64 + tt * 16 + fr];
            const float rs = __builtin_amdgcn_rsqf(tot * (1.0f / 128.0f) + EPS);
#pragma unroll
            for (int vt = 0; vt < 4; ++vt) {
                const int vd0 = (vh * 4 + vt) * 16 + g * 4;
                const f32x4 nw = *(const f32x4*)(hnw + h * 128 + vd0);
                const float g0 = bf2f(gp[vt].x & 0xffffu), g1 = bf2f(gp[vt].x >> 16), g2 = bf2f(gp[vt].y & 0xffffu), g3 = bf2f(gp[vt].y >> 16);
                u32x2 w; w.x = cvt_pk_bf16(O[vt][0] * rs * nw[0] * g0, O[vt][1] * rs * nw[1] * g1);
                w.y = cvt_pk_bf16(O[vt][2] * rs * nw[2] * g2, O[vt][3] * rs * nw[3] * g3);
                *(u32x2*)(mix + orow * D + 512 + h * 128 + vd0) = w;
            }
        }
        BAR_LDS();
    }
}

__device__ __forceinline__ void ctx_proj_unit(LAS unsigned char* lds, const float* __restrict__ ctx, const float* __restrict__ nw, const float* __restrict__ modc, const bf16_t* __restrict__ WIN,
                                              const float* __restrict__ lbl, bf16_t* __restrict__ proj, int unit, int tid) {
    constexpr int AST = 2064;
    const int lane = tid & 63, wid = tid >> 6, fr = lane & 15, g = lane >> 4;
    const int rb = unit / 20, gq = unit % 20, gsel = gq >> 2, cb = gq & 3;
    const int gidx = gsel == 0 ? 1 : gsel == 1 ? 2 : gsel + 2;
#pragma unroll 1
    for (int rq = 0; rq < 2; ++rq) {
        f32x4 v[4][4]; float s[4];
#pragma unroll
        for (int rr = 0; rr < 4; ++rr) { const float* xrow = ctx + (size_t)(rb * 64 + wid * 8 + rq * 4 + rr) * D; s[rr] = 0.f;
#pragma unroll
            for (int j = 0; j < 4; ++j) v[rr][j] = *(const f32x4*)(xrow + 4 * lane + 256 * j); }
#pragma unroll
        for (int rr = 0; rr < 4; ++rr) {
#pragma unroll
            for (int j = 0; j < 4; ++j) s[rr] += (v[rr][j].x * v[rr][j].x + v[rr][j].y * v[rr][j].y) + (v[rr][j].z * v[rr][j].z + v[rr][j].w * v[rr][j].w);
            const float r = __builtin_amdgcn_rsqf(wave_sum(s[rr]) * (1.f / D) + EPS); const int lr = wid * 8 + rq * 4 + rr;
#pragma unroll
            for (int j = 0; j < 4; ++j) { const int c = 4 * lane + 256 * j;
                const f32x4 ww = *(const f32x4*)(nw + c), sh = *(const f32x4*)(modc + c), sc = *(const f32x4*)(modc + 1024 + c);
                const f32x4 y = v[rr][j] * r * ww * (sc + 1.0f) + sh;
                u32x2 o; o.x = cvt_pk_bf16(y.x, y.y); o.y = cvt_pk_bf16(y.z, y.w);
                *(LAS u32x2*)(lds + lr * AST + c * 2) = o; }
        }
    }
    __syncthreads();
    const int cg0 = cb * 128 + wid * 16;
    const bf16_t* wrow = WIN + (size_t)(gidx * 512 + cg0 + fr) * D + g * 8;
    f32x4 acc[4];
#pragma unroll
    for (int rt = 0; rt < 4; ++rt) acc[rt] = (f32x4){0.f, 0.f, 0.f, 0.f};
#pragma unroll 16
    for (int ks = 0; ks < 32; ++ks) {
        const bf16x8 Bw = *(const bf16x8*)(wrow + ks * 32);
#pragma unroll
        for (int rt = 0; rt < 4; ++rt) { const bf16x8 Aa = *(const LAS bf16x8*)(lds + (rt * 16 + fr) * AST + (ks * 32 + g * 8) * 2);
            acc[rt] = __builtin_amdgcn_mfma_f32_16x16x32_bf16(Aa, Bw, acc[rt], 0, 0, 0); }
    }
    const int cg = cg0 + fr, hd = gidx < 3 ? 64 : 128, h = gidx < 3 ? (cg >> 6) : (cg >> 7), d = cg & (hd - 1);
    float lb = 0.f;
    if (gidx == 4 || gidx == 5) { const int k = (gidx - 4) * 512 + cg; lb = 1.0f / (1.0f + expf(lbl[1024 + k] - lbl[k])); }
    bf16_t* base = proj + (size_t)gidx * PLANE;
#pragma unroll
    for (int rt = 0; rt < 4; ++rt) {
        const int row = M + rb * 64 + rt * 16 + g * 4;
        float v[4];
#pragma unroll
        for (int j = 0; j < 4; ++j) { v[j] = acc[rt][j]; if (gidx == 4 || gidx == 5) v[j] = flog(lb + (1.0f - lb) * fsigmoid(v[j])); }
        if (gidx == 2) { u32x2 w; w.x = cvt_pk_bf16(v[0], v[1]); w.y = cvt_pk_bf16(v[2], v[3]);
            *(u32x2*)(base + ((size_t)h * MT + (row & ~63) + d) * 64 + (row & 63)) = w; }
        else {
#pragma unroll
            for (int j = 0; j < 4; ++j) base[((size_t)h * MT + row + j) * hd + d] = (bf16_t)(cvt_pk_bf16(v[j], 0.f) & 0xffffu);
        }
    }
    __syncthreads();
}

constexpr int NPHASE = 15;
__global__ void __launch_bounds__(512, 2) fwd_kernel(Args a) {
    extern __shared__ __attribute__((aligned(16))) unsigned char lds_raw[];
    LAS unsigned char* lds = (LAS unsigned char*)lds_raw;
    const int tid = threadIdx.x, lane = tid & 63, wid = __builtin_amdgcn_readfirstlane(tid >> 6);
    const int G = gridDim.x, bid = blockIdx.x;
    const int gw = bid * 8 + wid, NGW = G * 8;
    unsigned char* ws = a.ws;
    float* MOD = (float*)(ws + WS_MOD); float* MODC = MOD + 2 * 2 * 6144;
    float* SBUP = (float*)(ws + WS_SB); float* SBOD = SBUP + 2 * 2 * 2 * DFF;
    float* SSQ = (float*)(ws + WS_SSQ);
    float* HDEC = (float*)(ws + WS_HDEC);
    bf16_t* HKVC = (bf16_t*)(ws + WS_HKVC);
    bf16_t* WIN = (bf16_t*)(ws + WS_WIN); bf16_t* WOUT = (bf16_t*)(ws + WS_WOUT); bf16_t* ODIN = (bf16_t*)(ws + WS_ODIN); bf16_t* ODOUT = (bf16_t*)(ws + WS_ODOUT);
    bf16_t* UP = (bf16_t*)(ws + WS_UP); bf16_t* DOWN = (bf16_t*)(ws + WS_DOWN);
    bf16_t* HA = (bf16_t*)(ws + WS_HA) + (size_t)256 * D;
    bf16_t* PROJ = (bf16_t*)(ws + WS_PROJ); bf16_t* TB = PROJ; bf16_t* PB = PROJ;
    bf16_t* MIX = (bf16_t*)(ws + WS_MIX); bf16_t* ZB = MIX;
    bf16_t* XB = (bf16_t*)(ws + WS_PROJ + 96 * MiB);
    bf16_t* STATE = (bf16_t*)a.out;
    const int lo = a.ph_lo, hi = a.ph_hi;
    volatile LAS unsigned* bst = (volatile LAS unsigned*)(lds + LDS_BYTES - 16);
    if (tid < 4) bst[tid] = 0u;
    __syncthreads();
    XcdBarrier xbar; xbar.bar = (unsigned*)(ws + WS_BAR); xbar.x = 0; xbar.st = bst;
    if (hi - lo > 1) {
        if (lo < 0) cg::this_grid().sync();
        xbar = xcd_barrier_post((unsigned*)(ws + WS_BAR), bst);
    }
#ifndef PH_MASK
#define PH_MASK 0x7fff
#endif
#define IN(k) (((PH_MASK >> (k)) & 1) && lo <= (k) && (k) < hi)
#define SEAM(k) do { if (IN(k) && IN((k) + 1)) xcd_barrier(xbar); } while (0)

    if (IN(0)) {
        LAS float* scr = (LAS float*)(lds + wid * 16384);
        constexpr int I_WIN = 16 * 128, I_WOUT = 16 * 32, I_UP = 16 * 176, I_DOWN = 44 * 32;
        constexpr int I_ODOUT = 16 * 32, NIT = I_WIN + I_WOUT + I_UP + I_DOWN + I_ODOUT;
        const bool bal = (G == 256);
        const int ibase = bal ? (bid < 192 ? bid * 23 : 4416 + (bid - 192) * 45) : gw, iend = bal ? ibase + (bid < 192 ? 23 : 45) : NIT, istep = bal ? 8 : NGW;
        static_assert(192 * 23 + 64 * 45 == NIT, "transpose item split");
        for (int it = ibase + (bal ? wid : 0); it < iend; it += istep) {
            int r = it;
            if (r < I_WIN) { transpose_item<0, false>(a.ev_w_in, D, EVN, WIN, scr, r, lane); continue; } r -= I_WIN;
            if (r < I_WOUT) { transpose_item<0, false>(a.ev_w_out, D, D, WOUT, scr, r, lane); continue; } r -= I_WOUT;
            if (r < I_UP) { transpose_item<1, false>(a.ffn_w_up, D, 2 * DFF, UP, scr, r, lane); continue; } r -= I_UP;
            if (r < I_DOWN) { transpose_item<0, false>(a.ffn_w_down, DFF, D, DOWN, scr, r, lane); continue; } r -= I_DOWN;
            transpose_item<0, false>(a.od_w_out, D, D, ODOUT, scr, r, lane);
        }
        __syncthreads();
        LAS float* sv = (LAS float*)lds;
        LAS float* red = (LAS float*)(lds + 16384);
        for (int i = tid; i < 1024; i += 512) { sv[i] = a.c[i] / (1.0f + expf(-a.c[i])); sv[1024 + i] = a.c[1024 + i] / (1.0f + expf(-a.c[1024 + i])); sv[2048 + i] = a.c_ctx[i] / (1.0f + expf(-a.c_ctx[i])); }
        __syncthreads();
        for (int it = bid; it < 192; it += G) {
            const int l = it / 96, cc = it % 96, kg = tid >> 4, c4 = tid & 15;
            const float* Wp = a.ada_w + (size_t)l * D * 6144 + cc * 64 + c4 * 4;
            f32x4 a0 = (f32x4){0.f, 0.f, 0.f, 0.f}, a1 = a0, a2 = a0;
#pragma unroll 8
            for (int k = 0; k < 32; ++k) { const int kk = kg * 32 + k; const f32x4 w = __builtin_nontemporal_load((const f32x4*)(Wp + (size_t)kk * 6144));
                a0 += w * sv[kk]; a1 += w * sv[1024 + kk]; a2 += w * sv[2048 + kk]; }
            *(LAS f32x4*)(red + (kg * 3 + 0) * 64 + c4 * 4) = a0; *(LAS f32x4*)(red + (kg * 3 + 1) * 64 + c4 * 4) = a1; *(LAS f32x4*)(red + (kg * 3 + 2) * 64 + c4 * 4) = a2;
            __syncthreads();
            if (tid < 192) { const int v = tid / 64, col = tid % 64; float s = 0.f;
#pragma unroll 8
                for (int k = 0; k < 32; ++k) s += red[(k * 3 + v) * 64 + col];
                s += a.ada_b[l * 6144 + cc * 64 + col];
                if (v < 2) MOD[(l * 2 + v) * 6144 + cc * 64 + col] = s; else if (l == 0) MODC[cc * 64 + col] = s; }
            __syncthreads();
        }
    }
    SEAM(0);
    if (IN(1)) {
        for (int u = bid; u < 160; u += G) ctx_proj_unit(lds, a.ctx, a.norm_mix_w, MODC, WIN, a.hg_lb, PROJ, u, tid);
        for (int r = 2 * gw; r < M; r += 2 * NGW) norm_mod_row2(a.x + (size_t)r * D, a.x + (size_t)(r + 1) * D, a.norm_mix_w, MOD + (size_t)(r >> 13) * 6144, MOD + (size_t)(r >> 13) * 6144 + 1024, HA + (size_t)r * D, HA + (size_t)(r + 1) * D, lane);
        for (int r = gw; r < 2 * DFF; r += NGW) {
            const bf16_t* wrow; const float* sh; float* dst;
            if (r < 2 * 2 * DFF) { const int l = r / (2 * DFF), n = r % (2 * DFF); wrow = UP + (size_t)r * D; sh = MOD + (size_t)l * 2 * 6144 + 3072; dst = SBUP + (size_t)l * 2 * 2 * DFF + n; }
            else { const int n = r - 2 * 2 * DFF; wrow = ODIN + (size_t)n * D; sh = MOD + (size_t)2 * 6144; dst = SBOD + n; }
            const int dstride = (r < 2 * 2 * DFF) ? 2 * DFF : 3 * D;
            const u32x4 w0 = *(const u32x4*)(wrow + lane * 16), w1 = *(const u32x4*)(wrow + lane * 16 + 8);
            float s0 = 0.f, s1 = 0.f;
#pragma unroll
            for (int e = 0; e < 8; ++e) { const unsigned wa = w0[e >> 1], wb = w1[e >> 1];
                const float fa = bf2f((e & 1) ? (wa >> 16) : (wa & 0xffffu)), fb = bf2f((e & 1) ? (wb >> 16) : (wb & 0xffffu));
                s0 += fa * sh[lane * 16 + e] + fb * sh[lane * 16 + 8 + e]; s1 += fa * sh[6144 + lane * 16 + e] + fb * sh[6144 + lane * 16 + 8 + e]; }
            s0 = wave_sum(s0); s1 = wave_sum(s1);
            if (lane == 0) { dst[0] = s0; dst[dstride] = s1; }
        }
    }
    SEAM(1);
    if (IN(2)) {
        pg8::Gemm g{HA, WIN, D}; pg8::StaticOrder<false> S; S.init(M / 256, EVN / 256, G, bid);
        pg8::EpiProj E{PROJ, a.hg_lb};
        for (int rep = 0; rep < DUP2; ++rep) pg8::gemm_phase(lds, g, S, E);
    }
    SEAM(2);
    if (IN(3)) {
      for (int rep = 0; rep < DUP3; ++rep) {
#ifndef NO_NA
        for (int rep2 = 0; rep2 < DUPNA; ++rep2) for (int it = bid; it < 256; it += G) na_item(lds, PROJ, a.na_rpb, MIX, it, wid, lane);
#endif
        __syncthreads();
        for (int rep2 = 0; rep2 < DUPPA; ++rep2) { hg_passA_phase(lds, PROJ, a.hg_lb, STATE, HKVC, HDEC, bid, G, tid); __syncthreads(); }
        __syncthreads();
      }
    }
    SEAM(3);
    if (IN(4)) {
        for (int gid = bid * 512 + tid; gid < NCHAIN * 8192; gid += G * 512) {
            const int chain = gid >> 13, e = gid & 8191, vd = e >> 6, kp = e & 63;
            const float* dec = HDEC + (size_t)chain * NCHT * 128 + 2 * kp;
            float S0 = 0.f, S1 = 0.f;
            const unsigned* kvc = (const unsigned*)(HKVC + (size_t)chain * 4 * 16384) + vd * 64 + kp;
#pragma unroll
            for (int ci = 0; ci < 4; ++ci) { const unsigned kv = kvc[(size_t)ci * 8192]; const f32x2 d = *(const f32x2*)(dec + ci * 128);
                S0 = d.x * S0 + bf2f(kv & 0xffffu); S1 = d.y * S1 + bf2f(kv >> 16); }
            unsigned* st = (unsigned*)(STATE + (size_t)chain * NCH * 16384) + vd * 64 + kp;
#pragma unroll 1
            for (int j0 = 0; j0 < NCH; j0 += 32) {
                unsigned kv[32]; f32x2 dd[32];
#pragma unroll
                for (int k = 0; k < 32; ++k) { kv[k] = (j0 + k < NCH - 1) ? st[(size_t)(j0 + k) * 8192] : 0u; dd[k] = *(const f32x2*)(dec + (4 + j0 + k) * 128); }
#pragma unroll
                for (int k = 0; k < 32; ++k) {
                    st[(size_t)(j0 + k) * 8192] = cvt_pk_bf16(S0, S1);
                    S0 = dd[k].x * S0 + bf2f(kv[k] & 0xffffu); S1 = dd[k].y * S1 + bf2f(kv[k] >> 16);
                }
            }
        }
    }
    SEAM(4);
    if (IN(5)) {
      for (int rep = 0; rep < DUP5; ++rep) hg_passC_phase(lds, PROJ, a.hg_lb, a.hg_norm_w, STATE, MIX, bid, G, tid);
    }
    SEAM(5);
    if (IN(6)) {
        pg8::Gemm g{MIX, WOUT, D}; pg8::StaticOrder<false> S; S.init(M / 256, D / 256, G, bid);
        pg8::EpiResidB<true> E{a.x, nullptr, nullptr, MOD + 2048, HA, a.norm_ffn_w, MOD + 4096, SSQ};
        pg8::gemm_phase(lds, g, S, E);
    }
    SEAM(6);
    if (IN(7)) {
        pg8::Gemm g{HA, UP, D}; pg8::StaticOrder<true> S; S.init(66, 22, G, bid);
        pg8::EpiConvGlu E{TB, a.ffn_conv_w, a.ffn_conv_b, (LAS float*)(lds + XCH_OFF), SSQ, SBUP};
        pg8::gemm_phase(lds, g, S, E);
        {
            constexpr int J_ODIN = 16 * 96, J_UP = 16 * 176, NJ = J_ODIN + J_UP;
            const bool idle = (G == 256);
            const int w0 = idle ? (bid - 172) * 8 + wid : gw, nW = idle ? 84 * 8 : NGW;
            if (!idle || bid >= 172) {
                LAS float* scr = (LAS float*)(lds + wid * 16384);
                LAS float* shl = (LAS float*)(lds + 8 * 16384);
                for (int i = tid; i < 1024; i += 512) { shl[i] = MOD[2 * 6144 + i]; shl[1024 + i] = MOD[3 * 6144 + i]; shl[2048 + i] = MOD[2 * 6144 + 3072 + i]; shl[3072 + i] = MOD[3 * 6144 + 3072 + i]; }
                __syncthreads();
                for (int it = w0; it < NJ; it += nW) {
                    int r = it;
                    if (r < J_UP) { transpose_item<1, true>(a.ffn_w_up + (size_t)D * 2 * DFF, D, 2 * DFF, UP + (size_t)2 * DFF * D, scr, r, lane, shl + 2048, SBUP + (size_t)2 * 2 * DFF, 2 * DFF); continue; } r -= J_UP;
                    transpose_item<2, true>(a.od_w_in, D, 3 * D, ODIN, scr, r, lane, shl, SBOD, 3 * D);
                }
                __syncthreads();
            }
        }
    }
    SEAM(7);
    if (IN(8)) {
        pg8::Gemm g{TB, DOWN, DFF}; pg8::StaticOrder<false> S; S.init(M / 256, D / 256, G, bid);
        pg8::EpiResidB<false> E{HA, a.norm_ffn_w, MOD + 4096, MOD + 5120, HA, a.norm_mix_w + D, MOD + 2 * 6144 + 1024, SSQ + M};
        pg8::gemm_phase(lds, g, S, E);
    }
    SEAM(8);
    if (IN(9)) {
        pg8::Gemm g{HA, ODIN, D}; pg8::StaticOrder<false> S; S.init(M / 256, 8, G, bid);
        pg8::EpiMulPair E{PB, SSQ + M, SBOD};
        pg8::gemm_phase(lds, g, S, E);
    }
    SEAM(9);
    if (IN(10)) {
        pg8::Gemm g{HA, ODIN + (size_t)2048 * D, D}; pg8::StaticOrder<false> S; S.init(M / 256, 4, G, bid);
        pg8::EpiGateConv E{PB, ZB, a.od_conv_w, a.od_conv_b, SSQ + M, SBOD};
        pg8::gemm_phase(lds, g, S, E);
    }
    SEAM(10);
    if (IN(11)) {
        pg8::Gemm g{ZB, ODOUT, D}; pg8::StaticOrder<false> S; S.init(M / 256, D / 256, G, bid);
        pg8::EpiResidB<false> E{HA, a.norm_mix_w + D, MOD + 2 * 6144 + 1024, MOD + 2 * 6144 + 2048, HA, a.norm_ffn_w + D, MOD + 2 * 6144 + 4096, SSQ + 2 * M};
        pg8::gemm_phase(lds, g, S, E);
    }
    SEAM(11);
    if (IN(12)) {
        pg8::Gemm g{HA, UP + (size_t)2 * DFF * D, D}; pg8::StaticOrder<true> S; S.init(66, 22, G, bid);
        pg8::EpiConvGlu E{TB, a.ffn_conv_w + 3 * DFF, a.ffn_conv_b + DFF, (LAS float*)(lds + XCH_OFF), SSQ + 2 * M, SBUP + 2 * 2 * DFF};
        pg8::gemm_phase(lds, g, S, E);
        {
            const bool idle = (G == 256);
            const int w0 = idle ? (bid - 172) * 8 + wid : gw, nW = idle ? 84 * 8 : NGW;
            if (!idle || bid >= 172) { LAS float* scr = (LAS float*)(lds + wid * 16384);
                for (int it = w0; it < 44 * 32; it += nW) transpose_item<0, false>(a.ffn_w_down + (size_t)DFF * D, DFF, D, DOWN + (size_t)D * DFF, scr, it, lane); }
        }
    }
    SEAM(12);
    const bool fuse_final = (G == 256) && (hi - lo > 1);
    if (IN(13)) {
        pg8::Gemm g{TB, DOWN + (size_t)D * DFF, DFF}; pg8::StaticOrder<false> S; S.init(M / 256, D / 256, G, bid);
        if (fuse_final) { pg8::EpiResidFinal E{HA, a.norm_ffn_w + D, MOD + 2 * 6144 + 4096, a.out, MOD + 2 * 6144 + 5120, a.final_norm_w, (float*)(ws + WS_XS), (unsigned*)(ws + WS_CNT), (LAS float*)(lds + XCH_OFF)}; pg8::gemm_phase(lds, g, S, E); }
        else { pg8::EpiResidOut E{HA, a.norm_ffn_w + D, MOD + 2 * 6144 + 4096, a.out, MOD + 2 * 6144 + 5120}; pg8::gemm_phase(lds, g, S, E); }
    }
    if (!fuse_final) SEAM(13);
    if (IN(14) && !fuse_final) {
        for (int r = gw; r < M; r += NGW) {
            float* xr = a.out + (size_t)r * D;
            f32x4 v[4]; float s = 0.f;
#pragma unroll
            for (int j = 0; j < 4; ++j) { v[j] = *(const f32x4*)(xr + 4 * lane + 256 * j); s += (v[j].x * v[j].x + v[j].y * v[j].y) + (v[j].z * v[j].z + v[j].w * v[j].w); }
            const float rr = __builtin_amdgcn_rsqf(wave_sum(s) * (1.f / D) + EPS);
#pragma unroll
            for (int j = 0; j < 4; ++j) { const f32x4 ww = *(const f32x4*)(a.final_norm_w + 4 * lane + 256 * j); *(f32x4*)(xr + 4 * lane + 256 * j) = v[j] * rr * ww; }
        }
    }
#undef IN
#undef SEAM
}

extern "C" void kernel_launch(void* const* d_in, const int* in_sizes, int n_in, void* d_out, int out_size, void* d_ws, size_t ws_size, hipStream_t stream) {
    static int grid = 0;
    if (grid == 0) {
        int dev = 0, cus = 0, per_cu = 0;
        hipGetDevice(&dev);
        hipDeviceGetAttribute(&cus, hipDeviceAttributeMultiprocessorCount, dev);
        if (hipFuncSetAttribute((const void*)fwd_kernel, hipFuncAttributeMaxDynamicSharedMemorySize, LDS_BYTES) != hipSuccess) fprintf(stderr, "kernel_launch: hipFuncSetAttribute failed\n");
        if (hipOccupancyMaxActiveBlocksPerMultiprocessor(&per_cu, (const void*)fwd_kernel, 512, LDS_BYTES) != hipSuccess || per_cu < 1) { fprintf(stderr, "kernel_launch: occupancy query says %d\n", per_cu); per_cu = 1; }
        (void)hipGetLastError();
        grid = cus > 0 ? cus : 256;
        if (ws_size < WS_END) fprintf(stderr, "kernel_launch: workspace too small (%zu)\n", ws_size);
    }
    Args a{};
    const float** p = (const float**)&a;
    for (int i = 0; i < 22; ++i) p[i] = (const float*)d_in[i];
    a.out = (float*)d_out; a.ws = (unsigned char*)d_ws;
    (void)hipMemsetAsync((char*)d_ws + WS_ZERO_LO, 0, WS_ZERO_BYTES, stream);
#if MK_SINGLE
    a.ph_lo = 0; a.ph_hi = NPHASE;
    void* args[] = {&a};
    hipError_t e = hipLaunchCooperativeKernel((const void*)fwd_kernel, dim3(grid), dim3(512), args, LDS_BYTES, stream);
    if (e != hipSuccess) fprintf(stderr, "cooperative launch failed: %s (grid %d)\n", hipGetErrorString(e), grid);
#else
    for (int ph = 0; ph < NPHASE; ++ph) { a.ph_lo = ph; a.ph_hi = ph + 1; hipLaunchKernelGGL(fwd_kernel, dim3(grid), dim3(512), LDS_BYTES, stream, a); }
#endif
}
```
